# Optimizing an MI355X kernel written in HIP

```python
import math
import jax, jax.numpy as jnp
from jax import lax
import numpy as np

D_MODEL = 2048
BATCH = 4
SEQ = 2048
DEPTH = 4

N_EVEN = (DEPTH + 1) // 2
N_ODD = DEPTH // 2
NORM_EPS = 1e-6
NEG_INF = -1e30
FORCE_SCORE = 1e30
TINY = 1e-30

D_A = D_MODEL
A_DK = 128
A_HEADS = D_A // 128
A_DV = D_A // A_HEADS
A_QK = A_HEADS * A_DK
A_CHUNK = 64

D_B = D_MODEL
B_HEADS = 16
B_DH = D_B // B_HEADS
B_KV = 4
B_HPG = B_HEADS // B_KV
B_KVW = B_KV * B_DH
CMP_LEN = 32
CMP_STRIDE = 16
SEL_LEN = 64
SEL_TOPK = 16
WIN = 512
WIN_QB = 128
SEL_QB = 32

D_RNN = 2560
RG_BLOCKS = 10
RG_BS = D_RNN // RG_BLOCKS
CONV_W = 4
RG_C = 8.0

EVEN_SIZES = (A_QK, A_QK, D_A, D_A, D_B, B_KVW, B_KVW, B_KVW, B_KVW, B_KVW, B_KVW, 3 * B_HEADS, D_B)
EVEN_IN = sum(EVEN_SIZES)
EVEN_SPLIT_AT = tuple(int(v) for v in np.cumsum(EVEN_SIZES)[:-1])
EVEN_MIX = D_A + D_B

kernel_name = "hybrid_hgrn2_nsa_rglru_trunk"


def rms_norm(x, w):
    xf = x.astype(jnp.float32)
    y = xf * lax.rsqrt(jnp.mean(xf * xf, axis=-1, keepdims=True) + NORM_EPS)
    return (y * w.astype(jnp.float32)).astype(x.dtype)


def alibi_slopes(n):
    return jnp.asarray(2.0 ** (-8.0 * np.arange(1, n + 1) / n), dtype=jnp.float32)


def hgrn2(q, fz, v, lb, gain):
    bsz, T, _ = q.shape
    f32 = jnp.float32
    qf = jax.nn.silu(q.astype(f32))
    fz = fz.astype(f32)
    f = lb + (1.0 - lb) * jax.nn.sigmoid(fz)
    logf = jnp.log(jnp.maximum(f, TINY))
    k = (1.0 - lb) * jax.nn.sigmoid(-fz)
    vf = v.astype(f32)
    nc = T // A_CHUNK

    def to_chunks(a, d):
        return a.reshape(bsz, nc, A_CHUNK, A_HEADS, d).transpose(1, 0, 3, 2, 4)

    qc, kc, gc, vc = to_chunks(qf, A_DK), to_chunks(k, A_DK), to_chunks(logf, A_DK), to_chunks(vf, A_DV)
    causal = jnp.tril(jnp.ones((A_CHUNK, A_CHUNK), dtype=bool))[None, None, :, :, None]

    def step(S, inp):
        qt, kt, gt, vt = inp
        b = jnp.cumsum(gt, axis=2)
        o_inter = jnp.einsum('bhtk,bhkv->bhtv', qt * jnp.exp(b), S)
        rel = b[:, :, :, None, :] - b[:, :, None, :, :]
        decay = jnp.exp(jnp.where(causal, rel, NEG_INF))
        att = jnp.einsum('bhtk,bhsk,bhtsk->bhts', qt, kt, decay)
        o = o_inter + jnp.einsum('bhts,bhsv->bhtv', att, vt)
        b_last = b[:, :, -1:, :]
        S = jnp.exp(b_last[:, :, 0, :])[..., None] * S + jnp.einsum('bhsk,bhsv->bhkv', kt * jnp.exp(b_last - b), vt)
        return S, o

    S0 = jnp.zeros((bsz, A_HEADS, A_DK, A_DV), f32)
    _, o = lax.scan(step, S0, (qc, kc, gc, vc))
    o = o.transpose(1, 0, 3, 2, 4).reshape(bsz, T, A_HEADS, A_DV)
    o = o * lax.rsqrt(jnp.mean(o * o, axis=-1, keepdims=True) + NORM_EPS)
    return (o.reshape(bsz, T, D_A) * gain.astype(f32)).astype(q.dtype)


def nsa(q, kc, vc, ks, vs, kw, vw, gate_logits, pe_k, w1_k, w2_k, pe_v, w1_v, w2_v):
    bsz, T, _ = q.shape
    f32 = jnp.float32
    dt = q.dtype
    scale = B_DH ** -0.5
    slopes = alibi_slopes(B_HEADS).reshape(B_KV, B_HPG)

    def heads(a, n):
        return a.reshape(bsz, T, n, B_DH).transpose(0, 2, 1, 3)

    qh = heads(q, B_HEADS).reshape(bsz, B_KV, B_HPG, T, B_DH)
    pos = np.arange(T)

    n_cmp = (T - CMP_LEN) // CMP_STRIDE + 1
    cmp_idx = np.arange(n_cmp)[:, None] * CMP_STRIDE + np.arange(CMP_LEN)[None, :]

    def compress(a, pe, w1, w2):
        blk = heads(a, B_KV)[:, :, cmp_idx] + pe
        hid = jax.nn.silu(blk.reshape(bsz, B_KV, n_cmp, CMP_LEN * B_DH) @ w1)
        return hid @ w2

    Kc = compress(kc, pe_k, w1_k, w2_k)
    Vc = compress(vc, pe_v, w1_v, w2_v)
    dist_c = pos[:, None] - cmp_idx[None, :, -1]
    mask_c = dist_c >= 0
    s = jnp.einsum('bghtd,bgnd->bghtn', qh, Kc).astype(f32) * scale - slopes[..., None, None] * dist_c.astype(np.float32)
    p_cmp = jnp.where(mask_c, jax.nn.softmax(jnp.where(mask_c, s, NEG_INF), axis=-1), 0.0)
    o_cmp = jnp.einsum('bghtn,bgnd->bghtd', p_cmp.astype(dt), Vc)

    n_slc = T // SEL_LEN
    c_start = np.arange(n_cmp) * CMP_STRIDE
    s_start = np.arange(n_slc) * SEL_LEN
    overlap = ((c_start[:, None] <= s_start[None, :] + SEL_LEN - 1) &
               (c_start[:, None] + CMP_LEN - 1 >= s_start[None, :])).astype(np.float32)
    imp = jnp.einsum('bghtn,nj->bgtj', p_cmp, overlap)
    blk = np.arange(n_slc)[None, :]
    cur = (pos // SEL_LEN)[:, None]
    valid = blk <= cur
    forced = (blk == 0) | (blk == cur) | (blk == cur - 1)
    score = jnp.where(forced, FORCE_SCORE, jnp.where(valid, imp, NEG_INF))
    topk = min(SEL_TOPK, n_slc)
    _, idx = lax.top_k(score, topk)

    Ks = heads(ks, B_KV).reshape(bsz, B_KV, n_slc, SEL_LEN, B_DH)
    Vs = heads(vs, B_KV).reshape(bsz, B_KV, n_slc, SEL_LEN, B_DH)
    nqb = T // SEL_QB
    q_blocks = qh.reshape(bsz, B_KV, B_HPG, nqb, SEL_QB, B_DH).transpose(3, 0, 1, 2, 4, 5)
    idx_blocks = idx.reshape(bsz, B_KV, nqb, SEL_QB, topk).transpose(2, 0, 1, 3, 4)
    t_blocks = jnp.arange(T).reshape(nqb, SEL_QB)
    bi = jnp.arange(bsz)[:, None, None, None]
    gi = jnp.arange(B_KV)[None, :, None, None]
    offs = jnp.arange(SEL_LEN)

    def sel_block(args):
        qb, ib, tb = args
        kg = Ks[bi, gi, ib].reshape(bsz, B_KV, SEL_QB, topk * SEL_LEN, B_DH)
        vg = Vs[bi, gi, ib].reshape(bsz, B_KV, SEL_QB, topk * SEL_LEN, B_DH)
        kpos = (ib[..., None] * SEL_LEN + offs).reshape(bsz, B_KV, SEL_QB, topk * SEL_LEN)
        d = (tb[None, None, :, None] - kpos)[:, :, None]
        sb = jnp.einsum('bghqd,bgqsd->bghqs', qb, kg).astype(f32) * scale - slopes[:, :, None, None] * d.astype(f32)
        pb = jax.nn.softmax(jnp.where(d >= 0, sb, NEG_INF), axis=-1).astype(dt)
        return jnp.einsum('bghqs,bgqsd->bghqd', pb, vg)

    o_sel = lax.map(sel_block, (q_blocks, idx_blocks, t_blocks))
    o_sel = o_sel.transpose(1, 2, 3, 0, 4, 5).reshape(bsz, B_KV, B_HPG, T, B_DH)

    n_wb = T // WIN_QB
    span = WIN + WIN_QB
    kpos_w = np.arange(n_wb)[:, None] * WIN_QB - WIN + np.arange(span)[None, :]
    kidx = np.clip(kpos_w, 0, T - 1)
    Kw = heads(kw, B_KV)[:, :, kidx]
    Vw = heads(vw, B_KV)[:, :, kidx]
    qw = qh.reshape(bsz, B_KV, B_HPG, n_wb, WIN_QB, B_DH)
    d_w = pos.reshape(n_wb, WIN_QB)[:, :, None] - kpos_w[:, None, :]
    mask_w = (d_w >= 0) & (d_w < WIN) & (kpos_w[:, None, :] >= 0)
    sw = jnp.einsum('bghnqd,bgnkd->bghnqk', qw, Kw).astype(f32) * scale - slopes[:, :, None, None, None] * d_w.astype(np.float32)
    pw = jax.nn.softmax(jnp.where(mask_w, sw, NEG_INF), axis=-1).astype(dt)
    o_win = jnp.einsum('bghnqk,bgnkd->bghnqd', pw, Vw).reshape(bsz, B_KV, B_HPG, T, B_DH)

    g = jax.nn.sigmoid(gate_logits.astype(f32)).reshape(bsz, T, B_KV, B_HPG, 3).transpose(0, 2, 3, 1, 4)
    o = (g[..., 0:1] * o_cmp.astype(f32) + g[..., 1:2] * o_sel.astype(f32) + g[..., 2:3] * o_win.astype(f32))
    return o.transpose(0, 3, 1, 2, 4).reshape(bsz, T, D_B).astype(dt)


def rglru(xb, conv_w, conv_b, w_a, b_a, w_i, b_i, lam):
    bsz, T, _ = xb.shape
    f32 = jnp.float32
    xp = jnp.pad(xb, ((0, 0), (CONV_W - 1, 0), (0, 0)))
    xc = sum(xp[:, j:j + T] * conv_w[j] for j in range(CONV_W)) + conv_b
    xg = xc.reshape(bsz, T, RG_BLOCKS, RG_BS)
    r = jax.nn.sigmoid(jnp.einsum('btnd,nde->btne', xg, w_a).reshape(bsz, T, D_RNN).astype(f32) + b_a.astype(f32))
    i = jax.nn.sigmoid(jnp.einsum('btnd,nde->btne', xg, w_i).reshape(bsz, T, D_RNN).astype(f32) + b_i.astype(f32))
    log_a = -RG_C * jax.nn.softplus(-lam.astype(f32)) * r
    a = jnp.exp(log_a)
    u = jnp.sqrt(jnp.maximum(-jnp.expm1(2.0 * log_a), 0.0)) * (i * xc.astype(f32))

    def combine(c1, c2):
        a1, b1 = c1
        a2, b2 = c2
        return a1 * a2, a2 * b1 + b2

    _, h = lax.associative_scan(combine, (a, u), axis=1)
    return h.astype(xb.dtype)


def setup_inputs(seed: int = 0) -> dict:
    key = jax.random.key(seed)
    ks = jax.random.split(key, 24)
    nrm = jax.random.normal
    f32 = jnp.float32
    lo, hi = 0.9 ** (1.0 / RG_C), 0.999 ** (1.0 / RG_C)
    u = jax.random.uniform(ks[21], (N_ODD, D_RNN), f32, minval=lo, maxval=hi)
    return {
        'x': nrm(ks[0], (BATCH, SEQ, D_MODEL), f32),
        'norm_w': 1.0 + 0.02 * nrm(ks[1], (DEPTH, D_MODEL), f32),
        'final_norm_w': 1.0 + 0.02 * nrm(ks[2], (D_MODEL,), f32),
        'even_w_in': nrm(ks[3], (N_EVEN, D_MODEL, EVEN_IN), f32) * D_MODEL ** -0.5,
        'even_w_out': nrm(ks[4], (N_EVEN, EVEN_MIX, D_MODEL), f32) * EVEN_MIX ** -0.5,
        'hgrn_lb_logits': 0.5 * nrm(ks[5], (N_EVEN, A_QK), f32),
        'hgrn_norm_w': 1.0 + 0.02 * nrm(ks[6], (N_EVEN, D_A), f32),
        'cmp_pe_k': 0.02 * nrm(ks[7], (N_EVEN, CMP_LEN, B_DH), f32),
        'cmp_w1_k': nrm(ks[8], (N_EVEN, CMP_LEN * B_DH, B_DH), f32) * (CMP_LEN * B_DH) ** -0.5,
        'cmp_w2_k': nrm(ks[9], (N_EVEN, B_DH, B_DH), f32) * B_DH ** -0.5,
        'cmp_pe_v': 0.02 * nrm(ks[10], (N_EVEN, CMP_LEN, B_DH), f32),
        'cmp_w1_v': nrm(ks[11], (N_EVEN, CMP_LEN * B_DH, B_DH), f32) * (CMP_LEN * B_DH) ** -0.5,
        'cmp_w2_v': nrm(ks[12], (N_EVEN, B_DH, B_DH), f32) * B_DH ** -0.5,
        'odd_w_in': nrm(ks[13], (N_ODD, D_MODEL, 2 * D_RNN), f32) * D_MODEL ** -0.5,
        'odd_w_out': nrm(ks[14], (N_ODD, D_RNN, D_MODEL), f32) * D_RNN ** -0.5,
        'rg_conv_w': nrm(ks[15], (N_ODD, CONV_W, D_RNN), f32) * CONV_W ** -0.5,
        'rg_conv_b': 0.01 * nrm(ks[16], (N_ODD, D_RNN), f32),
        'rg_w_a': nrm(ks[17], (N_ODD, RG_BLOCKS, RG_BS, RG_BS), f32) * RG_BS ** -0.5,
        'rg_b_a': 0.01 * nrm(ks[18], (N_ODD, D_RNN), f32),
        'rg_w_i': nrm(ks[19], (N_ODD, RG_BLOCKS, RG_BS, RG_BS), f32) * RG_BS ** -0.5,
        'rg_b_i': 0.01 * nrm(ks[20], (N_ODD, D_RNN), f32),
        'rg_lambda': jnp.log(u) - jnp.log1p(-u),
    }


def reference(x, norm_w, final_norm_w, even_w_in, even_w_out, hgrn_lb_logits, hgrn_norm_w,
              cmp_pe_k, cmp_w1_k, cmp_w2_k, cmp_pe_v, cmp_w1_v, cmp_w2_v,
              odd_w_in, odd_w_out, rg_conv_w, rg_conv_b, rg_w_a, rg_b_a, rg_w_i, rg_b_i, rg_lambda):
    lb_sm = jax.nn.softmax(hgrn_lb_logits.astype(jnp.float32), axis=0)
    lb_all = jnp.cumsum(lb_sm, axis=0) - lb_sm[0]
    for layer in range(DEPTH):
        h = rms_norm(x, norm_w[layer])
        if layer % 2 == 0:
            e = layer // 2
            (a_q, a_f, a_i, a_g, b_q, b_kc, b_vc, b_ks, b_vs, b_kw, b_vw, b_gate, b_g) = jnp.split(
                h @ even_w_in[e], EVEN_SPLIT_AT, axis=-1)
            ya = hgrn2(a_q, a_f, a_i, lb_all[e], hgrn_norm_w[e]) * jax.nn.silu(a_g)
            yb = nsa(b_q, b_kc, b_vc, b_ks, b_vs, b_kw, b_vw, b_gate,
                     cmp_pe_k[e], cmp_w1_k[e], cmp_w2_k[e], cmp_pe_v[e], cmp_w1_v[e], cmp_w2_v[e]) * jax.nn.silu(b_g)
            y = jnp.concatenate([ya, yb], axis=-1) @ even_w_out[e]
        else:
            o = layer // 2
            xb, g = jnp.split(h @ odd_w_in[o], [D_RNN], axis=-1)
            hr = rglru(xb, rg_conv_w[o], rg_conv_b[o], rg_w_a[o], rg_b_a[o], rg_w_i[o], rg_b_i[o], rg_lambda[o])
            y = (hr * jax.nn.silu(g)) @ odd_w_out[o]
        x = x + y.astype(x.dtype)
    return rms_norm(x, final_norm_w)
```

```cpp
#ifndef CPU_SHIM
#include <hip/hip_runtime.h>
#include <hip/hip_cooperative_groups.h>
#include <cstdio>
namespace cg = cooperative_groups;
#define DEVI __device__ __forceinline__
#else
#include <cmath>
#include <cstring>
#include <cstdio>
#include <cstdlib>
#define DEVI static inline
#endif

#ifndef NB
#define NB 4
#endif

typedef unsigned short bf16_t;

constexpr int T_ = 2048;
constexpr int D_ = 2048;
constexpr int M_ = NB * T_;
constexpr int EIN = 15408;
constexpr int EIN_PAD = 15488;
constexpr int OIN = 5120;
constexpr int PA_W = 6144;
constexpr int PB_W = EIN_PAD - PA_W;
constexpr int DR = 2560;
constexpr int C_AQ = 0, C_AF = 2048, C_AI = 4096, C_AG = 6144, C_BQ = 8192, C_KC = 10240, C_VC = 10752,
              C_KS = 11264, C_VS = 11776, C_KW = 12288, C_VW = 12800, C_GT = 13312, C_BG = 13360;
constexpr int NCMP = 127;
constexpr float NORM_EPS = 1e-6f;

DEVI unsigned f_as_u(float f) {
#ifndef CPU_SHIM
  return __float_as_uint(f);
#else
  unsigned u; memcpy(&u, &f, 4); return u;
#endif
}
DEVI float u_as_f(unsigned u) {
#ifndef CPU_SHIM
  return __uint_as_float(u);
#else
  float f; memcpy(&f, &u, 4); return f;
#endif
}
DEVI bf16_t f2bf(float f) {
  unsigned u = f_as_u(f);
  u += 0x7FFFu + ((u >> 16) & 1u);
  return (bf16_t)(u >> 16);
}
DEVI float bf2f(bf16_t h) { return u_as_f(((unsigned)h) << 16); }
DEVI float sigmoidf_(float x) { return 1.0f / (1.0f + expf(-x)); }
DEVI float siluf_(float x) { return x / (1.0f + expf(-x)); }
DEVI float softplusf_(float x) { return x > 20.f ? x : log1pf(expf(x)); }

struct Params;

struct Params {
  const float *x, *norm_w, *final_norm_w, *even_w_in, *even_w_out, *hgrn_lb_logits, *hgrn_norm_w,
      *cmp_pe_k, *cmp_w1_k, *cmp_w2_k, *cmp_pe_v, *cmp_w1_v, *cmp_w2_v, *odd_w_in, *odd_w_out,
      *rg_conv_w, *rg_conv_b, *rg_w_a, *rg_b_a, *rg_w_i, *rg_b_i, *rg_lambda;
  float* out;
  float* X;
  bf16_t* Hb;
  bf16_t* Wt_ein;
  bf16_t* Wt_eout;
  bf16_t* Wt_oin;
  bf16_t* Wt_oout;
  float* PA;
  bf16_t* PB;
  float* PO;
  bf16_t* Ymix;
  float* RS;
  float* HID;
  float* KC;
  float* VC;
  float* IMP;
  int* SELM;
  float* OA;
  float* PCMP;
  float* YB;
  float* XC;
  float* AA;
  float* UU;
};


DEVI float pbv(const Params& p, long row, int col) { return bf2f(p.PB[row * PB_W + (col - PA_W)]); }

constexpr long N_WT = 2L * EIN_PAD * D_ + 2L * D_ * 4096 + 2L * OIN * D_ + 2L * D_ * DR;

DEVI void st_wt(const Params& p, long g) {
  const long n0 = 2L * EIN_PAD * D_, n1 = 2L * D_ * 4096, n2 = 2L * OIN * D_;
  if (g < n0) {
    int e = (int)(g / ((long)EIN_PAD * D_)); long r = g % ((long)EIN_PAD * D_);
    int n = (int)(r / D_), k = (int)(r % D_);
    float v = n < EIN ? p.even_w_in[((long)e * D_ + k) * EIN + n] : 0.f;
    p.Wt_ein[g] = f2bf(v);
    return;
  }
  g -= n0;
  if (g < n1) {
    int e = (int)(g / ((long)D_ * 4096)); long r = g % ((long)D_ * 4096);
    int n = (int)(r / 4096), k = (int)(r % 4096);
    p.Wt_eout[g] = f2bf(p.even_w_out[((long)e * 4096 + k) * D_ + n]);
    return;
  }
  g -= n1;
  if (g < n2) {
    int e = (int)(g / ((long)OIN * D_)); long r = g % ((long)OIN * D_);
    int n = (int)(r / D_), k = (int)(r % D_);
    p.Wt_oin[g] = f2bf(p.odd_w_in[((long)e * D_ + k) * OIN + n]);
    return;
  }
  g -= n2;
  {
    int e = (int)(g / ((long)D_ * DR)); long r = g % ((long)D_ * DR);
    int n = (int)(r / DR), k = (int)(r % DR);
    p.Wt_oout[g] = f2bf(p.odd_w_out[((long)e * DR + k) * D_ + n]);
  }
}

DEVI void st_copy(const Params& p, long g) { p.X[g] = p.x[g]; }

DEVI void st_rowss(const Params& p, long g) {
  const float* r = p.X + g * 128;
  float s = 0.f;
  for (int i = 0; i < 128; ++i) s += r[i] * r[i];
  p.RS[g] = s;
}
DEVI float row_rstd(const Params& p, long row) {
  float s = 0.f;
  for (int i = 0; i < 16; ++i) s += p.RS[row * 16 + i];
  return 1.0f / sqrtf(s * (1.0f / D_) + NORM_EPS);
}
DEVI void st_norm(const Params& p, int layer, long g) {
  long row = g / D_; int c = (int)(g % D_);
  p.Hb[g] = f2bf(p.X[g] * row_rstd(p, row) * p.norm_w[layer * D_ + c]);
}
DEVI void st_final(const Params& p, long g) {
  long row = g / D_; int c = (int)(g % D_);
  p.out[g] = p.X[g] * row_rstd(p, row) * p.final_norm_w[c];
}

DEVI void st_hgrn_prep(const Params& p, int e, long g) {
  long row = g / 2048; int c = (int)(g % 2048);
  float* pr = p.PA + row * PA_W;
  float lb = 0.f;
  if (e == 1) lb = sigmoidf_(p.hgrn_lb_logits[2048 + c] - p.hgrn_lb_logits[c]);
  float q = pr[C_AQ + c], fz = pr[C_AF + c];
  pr[C_AQ + c] = siluf_(q);
  pr[C_AF + c] = lb + (1.0f - lb) * sigmoidf_(fz);
}
DEVI void st_hgrn_rec(const Params& p, long g) {
  int v = (int)(g % 128); int h = (int)((g / 128) % 16); int b = (int)(g / 2048);
  float S[128];
#pragma unroll
  for (int k = 0; k < 128; ++k) S[k] = 0.f;
  for (int t = 0; t < T_; ++t) {
    long row = (long)b * T_ + t;
    const float* pr = p.PA + row * PA_W;
    const float* qf = pr + C_AQ + h * 128;
    const float* ff = pr + C_AF + h * 128;
    float vv = pr[C_AI + h * 128 + v];
    float o = 0.f;
#pragma unroll
    for (int k = 0; k < 128; ++k) {
      float f = ff[k];
      S[k] = f * S[k] + (1.0f - f) * vv;
      o += qf[k] * S[k];
    }
    p.OA[row * 2048 + h * 128 + v] = o;
  }
}
DEVI void st_hgrn_post(const Params& p, int e, long g) {
  long row = g / 16; int h = (int)(g % 16);
  const float* o = p.OA + row * 2048 + h * 128;
  float s = 0.f;
  for (int i = 0; i < 128; ++i) s += o[i] * o[i];
  float rstd = 1.0f / sqrtf(s * (1.0f / 128) + NORM_EPS);
  for (int i = 0; i < 128; ++i) {
    int c = h * 128 + i;
    float y = o[i] * rstd * p.hgrn_norm_w[e * 2048 + c] * siluf_(pbv(p, row, C_AG + c));
    p.Ymix[row * 4096 + c] = f2bf(y);
  }
}

DEVI void st_cmp_hid(const Params& p, int e, long g) {
  int eo = (int)(g % 128); long r = g / 128;
  int n = (int)(r % NCMP); r /= NCMP;
  int gg = (int)(r % 4); r /= 4;
  int b = (int)(r % NB); int kv = (int)(r / NB);
  const float* pe = (kv ? p.cmp_pe_v : p.cmp_pe_k) + (long)e * 32 * 128;
  const float* w1 = (kv ? p.cmp_w1_v : p.cmp_w1_k) + (long)e * 4096 * 128;
  int col = (kv ? C_VC : C_KC) + gg * 128;
  float acc = 0.f;
  for (int j = 0; j < 32; ++j) {
    const long srow = (long)b * T_ + 16 * n + j;
    for (int d = 0; d < 128; ++d) acc += (pbv(p, srow, col + d) + pe[j * 128 + d]) * w1[(long)(j * 128 + d) * 128 + eo];
  }
  p.HID[g] = siluf_(acc);
}
DEVI void st_cmp_out(const Params& p, int e, long g) {
  int eo = (int)(g % 128); long r = g / 128;
  int kv = (int)(r / ((long)NCMP * 4 * NB));
  const float* w2 = (kv ? p.cmp_w2_v : p.cmp_w2_k) + (long)e * 128 * 128;
  const float* hid = p.HID + r * 128;
  float acc = 0.f;
  for (int i = 0; i < 128; ++i) acc += hid[i] * w2[i * 128 + eo];
  long half = (long)NB * 4 * NCMP * 128;
  if (kv) p.VC[g - half] = acc; else p.KC[g] = acc;
}

DEVI float alibi_slope(int head) { return exp2f(-0.5f * (float)(head + 1)); }

DEVI void st_cmp_attn(const Params& p, long g) {
  int t = (int)(g % T_); int head = (int)((g / T_) % 16); int b = (int)(g / ((long)T_ * 16));
  int gg = head >> 2;
  long row = (long)b * T_ + t;
  const float scale = 0.08838834764831845f;
  const float slope = alibi_slope(head);
  int nvalid = t < 31 ? 0 : ((t - 31) / 16 + 1);
  if (nvalid > NCMP) nvalid = NCMP;
  float* pc = p.PCMP + (row * 16 + head) * 128;
  const float* kc = p.KC + ((long)(b * 4 + gg) * NCMP) * 128;
  const float* vc = p.VC + ((long)(b * 4 + gg) * NCMP) * 128;
  float mx = -3.0e38f;
  {
    float q[128];
#pragma unroll
    for (int d = 0; d < 128; ++d) q[d] = pbv(p, row, C_BQ + head * 128 + d);
    for (int n = 0; n < nvalid; ++n) {
      float s = 0.f;
#pragma unroll
      for (int d = 0; d < 128; ++d) s += q[d] * kc[n * 128 + d];
      s = s * scale - slope * (float)(t - 16 * n - 31);
      pc[n] = s;
      mx = fmaxf(mx, s);
    }
  }
  float sum = 0.f;
  for (int n = 0; n < nvalid; ++n) { float e_ = expf(pc[n] - mx); pc[n] = e_; sum += e_; }
  float inv = nvalid > 0 ? 1.0f / sum : 0.f;
  float o[128];
#pragma unroll
  for (int d = 0; d < 128; ++d) o[d] = 0.f;
  for (int n = 0; n < nvalid; ++n) {
    float pn = pc[n] * inv;
    pc[n] = pn;
#pragma unroll
    for (int d = 0; d < 128; ++d) o[d] += pn * vc[n * 128 + d];
  }
  for (int n = nvalid; n < 128; ++n) pc[n] = 0.f;
  float* op = p.YB + row * 2048 + head * 128;
  const float g0 = sigmoidf_(pbv(p, row, C_GT + head * 3 + 0));
#pragma unroll
  for (int d = 0; d < 128; ++d) op[d] = g0 * o[d];
}

DEVI void st_imp(const Params& p, long g) {
  int j = (int)(g % 32); int gg = (int)((g / 32) % 4); long row = g / 128;
  int t = (int)(row % T_);
  int cur = t >> 6;
  int n0 = 4 * j - 1; if (n0 < 0) n0 = 0;
  int n1 = 4 * j + 3; if (n1 > NCMP - 1) n1 = NCMP - 1;
  float s = 0.f;
  for (int hh = 0; hh < 4; ++hh) {
    const float* pc = p.PCMP + (row * 16 + gg * 4 + hh) * 128;
    for (int n = n0; n <= n1; ++n) s += pc[n];
  }
  float sc;
  if (j == 0 || j == cur || j == cur - 1) sc = 1e30f;
  else if (j <= cur) sc = s;
  else sc = -1e30f;
  p.IMP[g] = sc;
}
DEVI void st_topk(const Params& p, long g) {
  const float* sc = p.IMP + g * 32;
  unsigned mask = 0;
  for (int j = 0; j < 32; ++j) {
    float sj = sc[j];
    int cnt = 0;
    for (int i = 0; i < 32; ++i) {
      float si = sc[i];
      cnt += (si > sj) || (si == sj && i < j);
    }
    if (cnt < 16) mask |= (1u << j);
  }
  p.SELM[g] = (int)mask;
}

DEVI void st_sel_attn(const Params& p, long g) {
  int vq = (int)(g & 3); long r = g >> 2;
  int t = (int)(r % T_); int head = (int)((r / T_) % 16); int b = (int)(r / ((long)T_ * 16));
  int gg = head >> 2;
  long row = (long)b * T_ + t;
  const float scale = 0.08838834764831845f;
  const float slope = alibi_slope(head);
  unsigned mask = (unsigned)p.SELM[row * 4 + gg];
  int cur = t >> 6;
  float q[128];
#pragma unroll
  for (int d = 0; d < 128; ++d) q[d] = pbv(p, row, C_BQ + head * 128 + d) * scale;
  float o[32];
#pragma unroll
  for (int d = 0; d < 32; ++d) o[d] = 0.f;
  float mx = -3.0e38f, l = 0.f;
  for (int j = 0; j <= cur; ++j) {
    if (!((mask >> j) & 1u)) continue;
    int kend = j * 64 + 63; if (kend > t) kend = t;
    for (int kp = j * 64; kp <= kend; ++kp) {
      const bf16_t* pk = p.PB + ((long)b * T_ + kp) * PB_W - PA_W;
      const bf16_t* kr = pk + C_KS + gg * 128;
      const bf16_t* vr = pk + C_VS + gg * 128 + vq * 32;
      float s = 0.f;
#pragma unroll
      for (int d = 0; d < 128; ++d) s += q[d] * bf2f(kr[d]);
      s -= slope * (float)(t - kp);
      if (s > mx) {
        float a = expf(mx - s);
        l *= a;
#pragma unroll
        for (int d = 0; d < 32; ++d) o[d] *= a;
        mx = s;
      }
      float pp = expf(s - mx);
      l += pp;
#pragma unroll
      for (int d = 0; d < 32; ++d) o[d] += pp * bf2f(vr[d]);
    }
  }
  float inv = sigmoidf_(pbv(p, row, C_GT + head * 3 + 1)) / l;
  float* op = p.YB + row * 2048 + head * 128 + vq * 32;
#pragma unroll
  for (int d = 0; d < 32; ++d) op[d] += o[d] * inv;
}

DEVI void st_win_attn(const Params& p, long g) {
  int vq = (int)(g & 3); long r = g >> 2;
  int t = (int)(r % T_); int head = (int)((r / T_) % 16); int b = (int)(r / ((long)T_ * 16));
  int gg = head >> 2;
  long row = (long)b * T_ + t;
  const float scale = 0.08838834764831845f;
  const float slope = alibi_slope(head);
  float q[128];
#pragma unroll
  for (int d = 0; d < 128; ++d) q[d] = pbv(p, row, C_BQ + head * 128 + d) * scale;
  float o[32];
#pragma unroll
  for (int d = 0; d < 32; ++d) o[d] = 0.f;
  float mx = -3.0e38f, l = 0.f;
  int k0 = t - 511; if (k0 < 0) k0 = 0;
  for (int kp = k0; kp <= t; ++kp) {
    const bf16_t* pk = p.PB + ((long)b * T_ + kp) * PB_W - PA_W;
    const bf16_t* kr = pk + C_KW + gg * 128;
    const bf16_t* vr = pk + C_VW + gg * 128 + vq * 32;
    float s = 0.f;
#pragma unroll
    for (int d = 0; d < 128; ++d) s += q[d] * bf2f(kr[d]);
    s -= slope * (float)(t - kp);
    if (s > mx) {
      float a = expf(mx - s);
      l *= a;
#pragma unroll
      for (int d = 0; d < 32; ++d) o[d] *= a;
      mx = s;
    }
    float pp = expf(s - mx);
    l += pp;
#pragma unroll
    for (int d = 0; d < 32; ++d) o[d] += pp * bf2f(vr[d]);
  }
  float inv = sigmoidf_(pbv(p, row, C_GT + head * 3 + 2)) / l;
  float* op = p.YB + row * 2048 + head * 128 + vq * 32;
#pragma unroll
  for (int d = 0; d < 32; ++d) {
    int c = head * 128 + vq * 32 + d;
    float y = (op[d] + o[d] * inv) * siluf_(pbv(p, row, C_BG + c));
    p.Ymix[row * 4096 + 2048 + c] = f2bf(y);
  }
}

DEVI void st_conv(const Params& p, int o, long g) {
  long row = g / DR; int c = (int)(g % DR);
  int t = (int)(row % T_);
  const float* cw = p.rg_conv_w + (long)o * 4 * DR;
  float acc = p.rg_conv_b[o * DR + c];
  for (int j = 0; j < 4; ++j) {
    int tt = t + j - 3;
    if (tt >= 0) acc += cw[j * DR + c] * p.PO[(row + j - 3) * OIN + c];
  }
  p.XC[g] = acc;
}
DEVI void st_gates(const Params& p, int o, long g) {
  long row = g / DR; int c = (int)(g % DR);
  int n = c >> 8, e = c & 255;
  const float* wa = p.rg_w_a + ((long)o * 10 + n) * 65536;
  const float* wi = p.rg_w_i + ((long)o * 10 + n) * 65536;
  const float* xr = p.XC + row * DR + n * 256;
  float ra = p.rg_b_a[o * DR + c], ri = p.rg_b_i[o * DR + c];
  for (int d = 0; d < 256; ++d) {
    float xv = xr[d];
    ra += xv * wa[d * 256 + e];
    ri += xv * wi[d * 256 + e];
  }
  float r = sigmoidf_(ra), ig = sigmoidf_(ri);
  float log_a = -8.0f * softplusf_(-p.rg_lambda[o * DR + c]) * r;
  float a = expf(log_a);
  float u = sqrtf(fmaxf(-expm1f(2.0f * log_a), 0.f)) * (ig * p.XC[g]);
  p.AA[g] = a;
  p.UU[g] = u;
}
DEVI void st_scan(const Params& p, long g) {
  int c = (int)(g % DR); int b = (int)(g / DR);
  float h = 0.f;
  for (int t = 0; t < T_; ++t) {
    long row = (long)b * T_ + t;
    h = p.AA[row * DR + c] * h + p.UU[row * DR + c];
    float gt = p.PO[row * OIN + DR + c];
    p.Ymix[row * DR + c] = f2bf(h * siluf_(gt));
  }
}

#ifndef CPU_SHIM
using bf16x8 = __attribute__((ext_vector_type(8))) short;
using f32x4 = __attribute__((ext_vector_type(4))) float;
using u32x4 = __attribute__((ext_vector_type(4))) unsigned int;
constexpr int G_BM = 128, G_BN = 128, G_BK = 64, G_LD = 72;
constexpr int SMEM_BYTES = 2 * G_BM * G_LD * 2;

__device__ void gemm_tile(const bf16_t* __restrict__ A, const bf16_t* __restrict__ Bt, float* __restrict__ C,
                          bf16_t* __restrict__ C2, int ldc, int K, int m0, int n0, int mode, bf16_t* smem, int tid) {
  bf16_t* sA = smem;
  bf16_t* sB = smem + G_BM * G_LD;
  const int wid = tid >> 6, lane = tid & 63, wr = wid >> 1, wc = wid & 1, fr = lane & 15, fq = lane >> 4;
  f32x4 acc[4][4];
#pragma unroll
  for (int i = 0; i < 4; ++i)
#pragma unroll
    for (int j = 0; j < 4; ++j) acc[i][j] = (f32x4){0.f, 0.f, 0.f, 0.f};
  u32x4 ra[4], rb[4];
  const int nk = K / G_BK;
#pragma unroll
  for (int i = 0; i < 4; ++i) {
    int c = tid + i * 256; int row = c >> 3, kq = c & 7;
    ra[i] = *reinterpret_cast<const u32x4*>(A + (long)(m0 + row) * K + kq * 8);
    rb[i] = *reinterpret_cast<const u32x4*>(Bt + (long)(n0 + row) * K + kq * 8);
  }
  for (int kt = 0; kt < nk; ++kt) {
#pragma unroll
    for (int i = 0; i < 4; ++i) {
      int c = tid + i * 256; int row = c >> 3, kq = c & 7;
      *reinterpret_cast<u32x4*>(sA + row * G_LD + kq * 8) = ra[i];
      *reinterpret_cast<u32x4*>(sB + row * G_LD + kq * 8) = rb[i];
    }
    __syncthreads();
    if (kt + 1 < nk) {
      const int k0 = (kt + 1) * G_BK;
#pragma unroll
      for (int i = 0; i < 4; ++i) {
        int c = tid + i * 256; int row = c >> 3, kq = c & 7;
        ra[i] = *reinterpret_cast<const u32x4*>(A + (long)(m0 + row) * K + k0 + kq * 8);
        rb[i] = *reinterpret_cast<const u32x4*>(Bt + (long)(n0 + row) * K + k0 + kq * 8);
      }
    }
#pragma unroll
    for (int ks = 0; ks < 2; ++ks) {
      bf16x8 af[4], bfr[4];
#pragma unroll
      for (int i = 0; i < 4; ++i) {
        af[i] = *reinterpret_cast<const bf16x8*>(sA + (wr * 64 + i * 16 + fr) * G_LD + ks * 32 + fq * 8);
        bfr[i] = *reinterpret_cast<const bf16x8*>(sB + (wc * 64 + i * 16 + fr) * G_LD + ks * 32 + fq * 8);
      }
#pragma unroll
      for (int i = 0; i < 4; ++i)
#pragma unroll
        for (int j = 0; j < 4; ++j)
          acc[i][j] = __builtin_amdgcn_mfma_f32_16x16x32_bf16(af[i], bfr[j], acc[i][j], 0, 0, 0);
    }
    __syncthreads();
  }
#pragma unroll
  for (int i = 0; i < 4; ++i)
#pragma unroll
    for (int j = 0; j < 4; ++j)
#pragma unroll
      for (int r = 0; r < 4; ++r) {
        const long row = m0 + wr * 64 + i * 16 + fq * 4 + r;
        const int col = n0 + wc * 64 + j * 16 + fr;
        if (mode == 2 && n0 >= PA_W) C2[row * PB_W + (col - PA_W)] = f2bf(acc[i][j][r]);
        else if (mode == 1) C[row * ldc + col] += acc[i][j][r];
        else C[row * ldc + col] = acc[i][j][r];
      }
}
#endif

enum StageKind {
  SK_WT, SK_COPY, SK_ROWSS, SK_NORM, SK_GEMM_EIN, SK_HGRN_PREP, SK_HGRN_REC, SK_HGRN_POST, SK_CMP_HID, SK_CMP_OUT,
  SK_CMP_ATTN, SK_IMP, SK_TOPK, SK_SEL_ATTN, SK_WIN_ATTN, SK_GEMM_EOUT, SK_GEMM_OIN, SK_CONV, SK_GATES,
  SK_SCAN, SK_GEMM_OOUT, SK_FINAL
};
constexpr int N_STAGES = 2 + 2 * 14 + 2 * 7 + 2;

DEVI int even_kind(int i) {
  switch (i) {
    case 0: return SK_ROWSS; case 1: return SK_NORM; case 2: return SK_GEMM_EIN; case 3: return SK_HGRN_PREP;
    case 4: return SK_HGRN_REC; case 5: return SK_HGRN_POST; case 6: return SK_CMP_HID; case 7: return SK_CMP_OUT;
    case 8: return SK_CMP_ATTN; case 9: return SK_IMP; case 10: return SK_TOPK; case 11: return SK_SEL_ATTN;
    case 12: return SK_WIN_ATTN; default: return SK_GEMM_EOUT;
  }
}
DEVI int odd_kind(int i) {
  switch (i) {
    case 0: return SK_ROWSS; case 1: return SK_NORM; case 2: return SK_GEMM_OIN; case 3: return SK_CONV;
    case 4: return SK_GATES; case 5: return SK_SCAN; default: return SK_GEMM_OOUT;
  }
}
DEVI void stage_desc(int s, int& kind, int& layer) {
  if (s == 0) { kind = SK_WT; layer = 0; return; }
  if (s == 1) { kind = SK_COPY; layer = 0; return; }
  s -= 2;
  for (int l = 0; l < 4; ++l) {
    int n = (l & 1) ? 7 : 14;
    if (s < n) {
      layer = l;
      kind = (l & 1) ? odd_kind(s) : even_kind(s);
      return;
    }
    s -= n;
  }
  layer = 4;
  kind = s == 0 ? SK_ROWSS : SK_FINAL;
}

DEVI long stage_threads(int kind) {
  switch (kind) {
    case SK_WT: return N_WT;
    case SK_COPY: return (long)M_ * D_;
    case SK_ROWSS: return (long)M_ * 16;
    case SK_NORM: return (long)M_ * D_;
    case SK_HGRN_PREP: return (long)M_ * 2048;
    case SK_HGRN_REC: return (long)NB * 16 * 128;
    case SK_HGRN_POST: return (long)M_ * 16;
    case SK_CMP_HID: return 2L * NB * 4 * NCMP * 128;
    case SK_CMP_OUT: return 2L * NB * 4 * NCMP * 128;
    case SK_CMP_ATTN: return (long)NB * 16 * T_;
    case SK_IMP: return (long)M_ * 4 * 32;
    case SK_TOPK: return (long)M_ * 4;
    case SK_SEL_ATTN: return (long)NB * 16 * T_ * 4;
    case SK_WIN_ATTN: return (long)NB * 16 * T_ * 4;
    case SK_CONV: return (long)M_ * DR;
    case SK_GATES: return (long)M_ * DR;
    case SK_SCAN: return (long)NB * DR;
    case SK_FINAL: return (long)M_ * D_;
    default: return 0;
  }
}

DEVI void stage_thread(const Params& p, int kind, int layer, long g) {
  const int e = layer >> 1;
  switch (kind) {
    case SK_WT: st_wt(p, g); break;
    case SK_COPY: st_copy(p, g); break;
    case SK_ROWSS: st_rowss(p, g); break;
    case SK_NORM: st_norm(p, layer, g); break;
    case SK_HGRN_PREP: st_hgrn_prep(p, e, g); break;
    case SK_HGRN_REC: st_hgrn_rec(p, g); break;
    case SK_HGRN_POST: st_hgrn_post(p, e, g); break;
    case SK_CMP_HID: st_cmp_hid(p, e, g); break;
    case SK_CMP_OUT: st_cmp_out(p, e, g); break;
    case SK_CMP_ATTN: st_cmp_attn(p, g); break;
    case SK_IMP: st_imp(p, g); break;
    case SK_TOPK: st_topk(p, g); break;
    case SK_SEL_ATTN: st_sel_attn(p, g); break;
    case SK_WIN_ATTN: st_win_attn(p, g); break;
    case SK_CONV: st_conv(p, e, g); break;
    case SK_GATES: st_gates(p, e, g); break;
    case SK_SCAN: st_scan(p, g); break;
    case SK_FINAL: st_final(p, g); break;
    default: break;
  }
}

struct GemmDesc { const bf16_t* A; const bf16_t* Bt; float* C; bf16_t* C2; int ldc, K, N, mode; };
DEVI bool gemm_desc(const Params& p, int kind, int layer, GemmDesc& d) {
  const int e = layer >> 1;
  switch (kind) {
    case SK_GEMM_EIN: d = {p.Hb, p.Wt_ein + (long)e * EIN_PAD * D_, p.PA, p.PB, PA_W, D_, EIN_PAD, 2}; return true;
    case SK_GEMM_EOUT: d = {p.Ymix, p.Wt_eout + (long)e * D_ * 4096, p.X, nullptr, D_, 4096, D_, 1}; return true;
    case SK_GEMM_OIN: d = {p.Hb, p.Wt_oin + (long)e * OIN * D_, p.PO, nullptr, OIN, D_, OIN, 0}; return true;
    case SK_GEMM_OOUT: d = {p.Ymix, p.Wt_oout + (long)e * D_ * DR, p.X, nullptr, D_, DR, D_, 1}; return true;
    default: return false;
  }
}

#ifndef CPU_SHIM
__global__ void __launch_bounds__(256) mega(Params p, int s_begin, int s_end) {
  __shared__ __attribute__((aligned(16))) bf16_t smem[SMEM_BYTES / 2];
  cg::grid_group grid = cg::this_grid();
  const int tid = threadIdx.x;
  for (int s = s_begin; s < s_end; ++s) {
    int kind, layer;
    stage_desc(s, kind, layer);
    GemmDesc gd;
    if (gemm_desc(p, kind, layer, gd)) {
      const int tm = M_ / G_BM, tn = gd.N / G_BN;
      for (int tile = blockIdx.x; tile < tm * tn; tile += gridDim.x) {
        int im = tile % tm, in_ = tile / tm;
        gemm_tile(gd.A, gd.Bt, gd.C, gd.C2, gd.ldc, gd.K, im * G_BM, in_ * G_BN, gd.mode, smem, tid);
      }
    } else {
      const long n = stage_threads(kind);
      for (long g = (long)blockIdx.x * 256 + tid; g < n; g += (long)gridDim.x * 256) stage_thread(p, kind, layer, g);
    }
    if (s + 1 < s_end) grid.sync();
  }
}

static size_t carve(size_t& off, size_t bytes) { size_t o = off; off += (bytes + 255) & ~(size_t)255; return o; }

extern "C" void kernel_launch(void* const* d_in, const int* in_sizes, int n_in, void* d_out, int out_size, void* d_ws,
                              size_t ws_size, hipStream_t stream) {
  Params p{};
  {
    const float* ins[22];
    for (int i = 0; i < 22; ++i) ins[i] = (const float*)d_in[i];
    p.x = ins[0]; p.norm_w = ins[1]; p.final_norm_w = ins[2]; p.even_w_in = ins[3]; p.even_w_out = ins[4];
    p.hgrn_lb_logits = ins[5]; p.hgrn_norm_w = ins[6]; p.cmp_pe_k = ins[7]; p.cmp_w1_k = ins[8]; p.cmp_w2_k = ins[9];
    p.cmp_pe_v = ins[10]; p.cmp_w1_v = ins[11]; p.cmp_w2_v = ins[12]; p.odd_w_in = ins[13]; p.odd_w_out = ins[14];
    p.rg_conv_w = ins[15]; p.rg_conv_b = ins[16]; p.rg_w_a = ins[17]; p.rg_b_a = ins[18]; p.rg_w_i = ins[19];
    p.rg_b_i = ins[20]; p.rg_lambda = ins[21];
  }
  p.out = (float*)d_out;
  char* ws = (char*)d_ws;
  size_t off = 0;
  p.X = (float*)(ws + carve(off, (size_t)M_ * D_ * 4));
  p.Hb = (bf16_t*)(ws + carve(off, (size_t)M_ * D_ * 2));
  p.Wt_ein = (bf16_t*)(ws + carve(off, 2ull * EIN_PAD * D_ * 2));
  p.Wt_eout = (bf16_t*)(ws + carve(off, 2ull * D_ * 4096 * 2));
  p.Wt_oin = (bf16_t*)(ws + carve(off, 2ull * OIN * D_ * 2));
  p.Wt_oout = (bf16_t*)(ws + carve(off, 2ull * D_ * DR * 2));
  p.PA = (float*)(ws + carve(off, (size_t)M_ * PA_W * 4));
  p.PO = p.PA;
  p.Ymix = (bf16_t*)(ws + carve(off, (size_t)M_ * 4096 * 2));
  p.RS = (float*)(ws + carve(off, (size_t)M_ * 16 * 4));
  p.HID = (float*)(ws + carve(off, 2ull * NB * 4 * NCMP * 128 * 4));
  p.KC = (float*)(ws + carve(off, (size_t)NB * 4 * NCMP * 128 * 4));
  p.VC = (float*)(ws + carve(off, (size_t)NB * 4 * NCMP * 128 * 4));
  p.IMP = (float*)(ws + carve(off, (size_t)M_ * 4 * 32 * 4));
  p.SELM = (int*)(ws + carve(off, (size_t)M_ * 4 * 4));
  size_t shared0 = off;
  p.PB = (bf16_t*)(ws + carve(off, (size_t)M_ * PB_W * 2));
  p.OA = (float*)(ws + carve(off, (size_t)M_ * 2048 * 4));
  p.PCMP = (float*)(ws + carve(off, (size_t)M_ * 16 * 128 * 4));
  p.YB = (float*)(ws + carve(off, (size_t)M_ * 2048 * 4));
  size_t end_even = off;
  off = shared0;
  p.XC = (float*)(ws + carve(off, (size_t)M_ * DR * 4));
  p.AA = (float*)(ws + carve(off, (size_t)M_ * DR * 4));
  p.UU = (float*)(ws + carve(off, (size_t)M_ * DR * 4));
  if (off < end_even) off = end_even;
  if (off > ws_size) { fprintf(stderr, "workspace too small: need %zu have %zu\n", off, ws_size); return; }

  static int grid_blocks = 0;
  if (!grid_blocks) {
    int dev = 0, cus = 0, per_cu = 0;
    hipGetDevice(&dev);
    hipDeviceGetAttribute(&cus, hipDeviceAttributeMultiprocessorCount, dev);
    hipOccupancyMaxActiveBlocksPerMultiprocessor(&per_cu, mega, 256, 0);
    if (per_cu > 4) per_cu = 4;
    if (per_cu < 1) per_cu = 1;
    grid_blocks = cus * per_cu;
  }
#ifdef MULTI_LAUNCH
#ifndef DBG_NST
#define DBG_NST N_STAGES
#endif
  for (int s = 0; s < DBG_NST; ++s) {
    int sb = s, se = s + 1;
    hipLaunchKernelGGL(mega, dim3(grid_blocks), dim3(256), 0, stream, p, sb, se);
  }
#else
  int sb = 0, se = N_STAGES;
  void* args[] = {&p, &sb, &se};
  hipError_t err = hipLaunchCooperativeKernel((void*)mega, dim3(grid_blocks), dim3(256), args, 0, stream);
  if (err != hipSuccess) fprintf(stderr, "cooperative launch failed: %s (grid %d)\n", hipGetErrorString(err), grid_blocks);
#endif
}
#endif
```

```cpp
#ifndef CPU_SHIM
#include <hip/hip_runtime.h>
#include <hip/hip_cooperative_groups.h>
#include <cstdio>
namespace cg = cooperative_groups;
#define DEVI __device__ __forceinline__
#else
#include <cmath>
#include <cstring>
#include <cstdio>
#include <cstdlib>
#define DEVI static inline
#endif

#ifndef NB
#define NB 4
#endif

typedef unsigned short bf16_t;

constexpr int T_ = 2048;
constexpr int D_ = 2048;
constexpr int M_ = NB * T_;
constexpr int EIN = 15408;
constexpr int EIN_PAD = 15616;
constexpr int OIN = 5120;
constexpr int PA_W = 6144;
constexpr int PB_W = EIN_PAD - PA_W;
constexpr int DR = 2560;
constexpr int C_AQ = 0, C_AF = 2048, C_AI = 4096, C_AG = 6144, C_BQ = 8192, C_KC = 10240, C_VC = 10752,
              C_KS = 11264, C_VS = 11776, C_KW = 12288, C_VW = 12800, C_GT = 13312, C_BG = 13360;
constexpr int NCMP = 127;
constexpr float NORM_EPS = 1e-6f;

DEVI unsigned f_as_u(float f) {
#ifndef CPU_SHIM
  return __float_as_uint(f);
#else
  unsigned u; memcpy(&u, &f, 4); return u;
#endif
}
DEVI float u_as_f(unsigned u) {
#ifndef CPU_SHIM
  return __uint_as_float(u);
#else
  float f; memcpy(&f, &u, 4); return f;
#endif
}
DEVI bf16_t f2bf(float f) {
  unsigned u = f_as_u(f);
  u += 0x7FFFu + ((u >> 16) & 1u);
  return (bf16_t)(u >> 16);
}
DEVI float bf2f(bf16_t h) { return u_as_f(((unsigned)h) << 16); }
DEVI float sigmoidf_(float x) { return 1.0f / (1.0f + expf(-x)); }
DEVI float siluf_(float x) { return x / (1.0f + expf(-x)); }
DEVI float softplusf_(float x) { return x > 20.f ? x : log1pf(expf(x)); }

struct Params;

struct Params {
  const float *x, *norm_w, *final_norm_w, *even_w_in, *even_w_out, *hgrn_lb_logits, *hgrn_norm_w,
      *cmp_pe_k, *cmp_w1_k, *cmp_w2_k, *cmp_pe_v, *cmp_w1_v, *cmp_w2_v, *odd_w_in, *odd_w_out,
      *rg_conv_w, *rg_conv_b, *rg_w_a, *rg_b_a, *rg_w_i, *rg_b_i, *rg_lambda;
  float* out;
  float* X;
  bf16_t* Hb;
  bf16_t* Wt_ein;
  bf16_t* Wt_eout;
  bf16_t* Wt_oin;
  bf16_t* Wt_oout;
  bf16_t* QS;
  float* LF;
  bf16_t* KK;
  bf16_t* AVT;
  float* LB;
  unsigned* BAR;
  bf16_t* KVC;
  bf16_t* W1T;
  float* ZC;
  float* C1;
  bf16_t* KCb;
  bf16_t* VCT;
  bf16_t* PB;
  bf16_t* XB;
  bf16_t* GS;
  bf16_t* LA;
  bf16_t* UB;
  float* SUMP;
  float* SUMH;
  bf16_t* Ymix;
  float* RS;
  float* HID;
  float* KC;
  float* VC;
  float* IMP;
  int* SELM;
  float* OA;
  float* PCMP;
  float* YB;
  bf16_t* VT;
  float* XC;
  bf16_t* XCb;
  float* SP;
  bf16_t* Wt_g;
  float* AA;
  float* UU;
};


DEVI float pbv(const Params& p, long row, int col) { return bf2f(p.PB[row * PB_W + (col - PA_W)]); }

constexpr long N_WT = 2L * EIN_PAD * D_ + 2L * D_ * 4096 + 2L * OIN * D_ + 2L * D_ * DR;

DEVI void st_wt(const Params& p, long g) {
  const long n0 = 2L * EIN_PAD * D_, n1 = 2L * D_ * 4096, n2 = 2L * OIN * D_;
  if (g < n0) {
    int e = (int)(g / ((long)EIN_PAD * D_)); long r = g % ((long)EIN_PAD * D_);
    int n = (int)(r / D_), k = (int)(r % D_);
    float v = n < EIN ? p.even_w_in[((long)e * D_ + k) * EIN + n] : 0.f;
    p.Wt_ein[g] = f2bf(v);
    return;
  }
  g -= n0;
  if (g < n1) {
    int e = (int)(g / ((long)D_ * 4096)); long r = g % ((long)D_ * 4096);
    int n = (int)(r / 4096), k = (int)(r % 4096);
    p.Wt_eout[g] = f2bf(p.even_w_out[((long)e * 4096 + k) * D_ + n]);
    return;
  }
  g -= n1;
  if (g < n2) {
    int e = (int)(g / ((long)OIN * D_)); long r = g % ((long)OIN * D_);
    int n = (int)(r / D_), k = (int)(r % D_);
    p.Wt_oin[g] = f2bf(p.odd_w_in[((long)e * D_ + k) * OIN + n]);
    return;
  }
  g -= n2;
  {
    int e = (int)(g / ((long)D_ * DR)); long r = g % ((long)D_ * DR);
    int n = (int)(r / DR), k = (int)(r % DR);
    p.Wt_oout[g] = f2bf(p.odd_w_out[((long)e * DR + k) * D_ + n]);
  }
}

DEVI void st_copy(const Params& p, long g) { p.X[g] = p.x[g]; }

DEVI void st_rowss(const Params& p, long g) {
  const float* r = p.X + g * 128;
  float s = 0.f;
  for (int i = 0; i < 128; ++i) s += r[i] * r[i];
  p.RS[g] = s;
}
DEVI float row_rstd(const Params& p, long row) {
  float s = 0.f;
  for (int i = 0; i < 16; ++i) s += p.RS[row * 16 + i];
  return 1.0f / sqrtf(s * (1.0f / D_) + NORM_EPS);
}
DEVI void st_norm(const Params& p, int layer, long g) {
  long row = g / D_; int c = (int)(g % D_);
  p.Hb[g] = f2bf(p.X[g] * row_rstd(p, row) * p.norm_w[layer * D_ + c]);
}
DEVI void st_final(const Params& p, long g) {
  long row = g / D_; int c = (int)(g % D_);
  p.out[g] = p.X[g] * row_rstd(p, row) * p.final_norm_w[c];
}


DEVI void st_hgrn_rec2(const Params& p, long g) {
  int v = (int)(g % 128); int h = (int)((g / 128) % 16); int b = (int)(g / 2048);
  float S[128];
#pragma unroll
  for (int k = 0; k < 128; ++k) S[k] = 0.f;
  for (int t = 0; t < T_; ++t) {
    long row = (long)b * T_ + t;
    const bf16_t* qf = p.QS + row * 2048 + h * 128;
    const float* lf = p.LF + row * 2048 + h * 128;
    const bf16_t* kk = p.KK + row * 2048 + h * 128;
    float vv = bf2f(p.AVT[(((long)b * 16 + h) * 128 + v) * T_ + t]);
    float o = 0.f;
#pragma unroll
    for (int k = 0; k < 128; ++k) {
      float f = expf(lf[k]);
      S[k] = f * S[k] + bf2f(kk[k]) * vv;
      o += bf2f(qf[k]) * S[k];
#ifndef CPU_SHIM
      if ((k & 15) == 15) asm volatile("" ::: "memory");
#endif
    }
    p.OA[row * 2048 + h * 128 + v] = o;
  }
}
DEVI void st_hgrn_post(const Params& p, int e, long g) {
  long row = g / 16; int h = (int)(g % 16);
  const float* o = p.OA + row * 2048 + h * 128;
  float s = 0.f;
  for (int i = 0; i < 128; ++i) s += o[i] * o[i];
  float rstd = 1.0f / sqrtf(s * (1.0f / 128) + NORM_EPS);
  for (int i = 0; i < 128; ++i) {
    int c = h * 128 + i;
    float y = o[i] * rstd * p.hgrn_norm_w[e * 2048 + c] * siluf_(pbv(p, row, C_AG + c));
    p.Ymix[row * 4096 + c] = f2bf(y);
  }
}

DEVI void st_cmp_hid(const Params& p, int e, long g) {
  int eo = (int)(g % 128); long r = g / 128;
  int n = (int)(r % NCMP); r /= NCMP;
  int gg = (int)(r % 4); r /= 4;
  int b = (int)(r % NB); int kv = (int)(r / NB);
  const float* pe = (kv ? p.cmp_pe_v : p.cmp_pe_k) + (long)e * 32 * 128;
  const float* w1 = (kv ? p.cmp_w1_v : p.cmp_w1_k) + (long)e * 4096 * 128;
  int col = (kv ? C_VC : C_KC) + gg * 128;
  float acc = 0.f;
  for (int j = 0; j < 32; ++j) {
    const long srow = (long)b * T_ + 16 * n + j;
    for (int d = 0; d < 128; ++d) acc += (pbv(p, srow, col + d) + pe[j * 128 + d]) * w1[(long)(j * 128 + d) * 128 + eo];
  }
  p.HID[g] = siluf_(acc);
}

DEVI void st_cmp_hid2(const Params& p, int e, long g) {
  int eo = (int)(g % 128); long r = g / 128;
  int n = (int)(r % NCMP); r /= NCMP;
  int kv = (int)(r / (NB * 4));
  const float* z = p.ZC + (r * 128 + n) * 256;
  float acc = z[eo] + z[256 + 128 + eo] + p.C1[(e * 2 + kv) * 128 + eo];
  p.HID[g] = siluf_(acc);
}

DEVI void st_cmp_hidout(const Params& p, int e, long g) {
  int eo = (int)(g % 128); long r = g / 128;
  int n = (int)(r % NCMP); long rb = r / NCMP;
  int kv = (int)(rb / (NB * 4));
  const float* z = p.ZC + (rb * 128 + n) * 256;
  const float* c1 = p.C1 + (e * 2 + kv) * 128;
  const float* w2 = (kv ? p.cmp_w2_v : p.cmp_w2_k) + (long)e * 128 * 128;
  float acc = 0.f;
  for (int i = 0; i < 128; ++i) acc += siluf_(z[i] + z[256 + 128 + i] + c1[i]) * w2[i * 128 + eo];
  long bg = rb % (NB * 4);
  if (kv) p.VCT[(bg * 128 + eo) * 128 + n] = f2bf(acc); else p.KCb[(bg * 128 + n) * 128 + eo] = f2bf(acc);
  if (n == 0) { if (kv) p.VCT[(bg * 128 + eo) * 128 + 127] = 0; else p.KCb[(bg * 128 + 127) * 128 + eo] = 0; }
}
DEVI void st_cmp_out(const Params& p, int e, long g) {
  int eo = (int)(g % 128); long r = g / 128;
  int kv = (int)(r / ((long)NCMP * 4 * NB));
  const float* w2 = (kv ? p.cmp_w2_v : p.cmp_w2_k) + (long)e * 128 * 128;
  const float* hid = p.HID + r * 128;
  float acc = 0.f;
  for (int i = 0; i < 128; ++i) acc += hid[i] * w2[i * 128 + eo];
  long half = (long)NB * 4 * NCMP * 128;
  if (kv) p.VC[g - half] = acc; else p.KC[g] = acc;
  {
    long rr = r % ((long)NCMP * 4 * NB);
    int n = (int)(rr % NCMP); long bg = rr / NCMP;
    if (kv) p.VCT[(bg * 128 + eo) * 128 + n] = f2bf(acc); else p.KCb[(bg * 128 + n) * 128 + eo] = f2bf(acc);
    if (n == 0) { if (kv) p.VCT[(bg * 128 + eo) * 128 + 127] = 0; else p.KCb[(bg * 128 + 127) * 128 + eo] = 0; }
  }
}

DEVI float alibi_slope(int head) { return exp2f(-0.5f * (float)(head + 1)); }

DEVI void st_cmp_attn(const Params& p, long g) {
  int t = (int)(g % T_); int head = (int)((g / T_) % 16); int b = (int)(g / ((long)T_ * 16));
  int gg = head >> 2;
  long row = (long)b * T_ + t;
  const float scale = 0.08838834764831845f;
  const float slope = alibi_slope(head);
  int nvalid = t < 31 ? 0 : ((t - 31) / 16 + 1);
  if (nvalid > NCMP) nvalid = NCMP;
  float* pc = p.PCMP + (row * 16 + head) * 128;
  const float* kc = p.KC + ((long)(b * 4 + gg) * NCMP) * 128;
  const float* vc = p.VC + ((long)(b * 4 + gg) * NCMP) * 128;
  float mx = -3.0e38f;
  {
    float q[128];
#pragma unroll
    for (int d = 0; d < 128; ++d) q[d] = pbv(p, row, C_BQ + head * 128 + d);
    for (int n = 0; n < nvalid; ++n) {
      float s = 0.f;
#pragma unroll
      for (int d = 0; d < 128; ++d) s += q[d] * kc[n * 128 + d];
      s = s * scale - slope * (float)(t - 16 * n - 31);
      pc[n] = s;
      mx = fmaxf(mx, s);
    }
  }
  float sum = 0.f;
  for (int n = 0; n < nvalid; ++n) { float e_ = expf(pc[n] - mx); pc[n] = e_; sum += e_; }
  float inv = nvalid > 0 ? 1.0f / sum : 0.f;
  float o[128];
#pragma unroll
  for (int d = 0; d < 128; ++d) o[d] = 0.f;
  for (int n = 0; n < nvalid; ++n) {
    float pn = pc[n] * inv;
    pc[n] = pn;
#pragma unroll
    for (int d = 0; d < 128; ++d) o[d] += pn * vc[n * 128 + d];
  }
  for (int n = nvalid; n < 128; ++n) pc[n] = 0.f;
  float* op = p.YB + row * 2048 + head * 128;
  const float g0 = sigmoidf_(pbv(p, row, C_GT + head * 3 + 0));
#pragma unroll
  for (int d = 0; d < 128; ++d) op[d] = g0 * o[d];
}

DEVI void st_imp(const Params& p, long g) {
  int j = (int)(g % 32); int gg = (int)((g / 32) % 4); long row = g / 128;
  int t = (int)(row % T_);
  int cur = t >> 6;
  int n0 = 4 * j - 1; if (n0 < 0) n0 = 0;
  int n1 = 4 * j + 3; if (n1 > NCMP - 1) n1 = NCMP - 1;
  float s = 0.f;
  for (int hh = 0; hh < 4; ++hh) {
    const float* pc = p.PCMP + (row * 16 + gg * 4 + hh) * 128;
    for (int n = n0; n <= n1; ++n) s += pc[n];
  }
  float sc;
  if (j == 0 || j == cur || j == cur - 1) sc = 1e30f;
  else if (j <= cur) sc = s;
  else sc = -1e30f;
  p.IMP[g] = sc;
}
DEVI void st_topk(const Params& p, long g) {
  const float* sc = p.IMP + g * 32;
  unsigned mask = 0;
  for (int j = 0; j < 32; ++j) {
    float sj = sc[j];
    int cnt = 0;
    for (int i = 0; i < 32; ++i) {
      float si = sc[i];
      cnt += (si > sj) || (si == sj && i < j);
    }
    if (cnt < 16) mask |= (1u << j);
  }
  p.SELM[g] = (int)mask;
}

DEVI void st_sel_attn(const Params& p, long g) {
  int vq = (int)(g & 3); long r = g >> 2;
  int t = (int)(r % T_); int head = (int)((r / T_) % 16); int b = (int)(r / ((long)T_ * 16));
  int gg = head >> 2;
  long row = (long)b * T_ + t;
  const float scale = 0.08838834764831845f;
  const float slope = alibi_slope(head);
  unsigned mask = (unsigned)p.SELM[row * 4 + gg];
  int cur = t >> 6;
  float q[128];
#pragma unroll
  for (int d = 0; d < 128; ++d) q[d] = pbv(p, row, C_BQ + head * 128 + d) * scale;
  float o[32];
#pragma unroll
  for (int d = 0; d < 32; ++d) o[d] = 0.f;
  float mx = -3.0e38f, l = 0.f;
  for (int j = 0; j <= cur; ++j) {
    if (!((mask >> j) & 1u)) continue;
    int kend = j * 64 + 63; if (kend > t) kend = t;
    for (int kp = j * 64; kp <= kend; ++kp) {
      const bf16_t* pk = p.PB + ((long)b * T_ + kp) * PB_W - PA_W;
      const bf16_t* kr = pk + C_KS + gg * 128;
      const bf16_t* vr = pk + C_VS + gg * 128 + vq * 32;
      float s = 0.f;
#pragma unroll
      for (int d = 0; d < 128; ++d) s += q[d] * bf2f(kr[d]);
      s -= slope * (float)(t - kp);
      if (s > mx) {
        float a = expf(mx - s);
        l *= a;
#pragma unroll
        for (int d = 0; d < 32; ++d) o[d] *= a;
        mx = s;
      }
      float pp = expf(s - mx);
      l += pp;
#pragma unroll
      for (int d = 0; d < 32; ++d) o[d] += pp * bf2f(vr[d]);
    }
  }
  float inv = sigmoidf_(pbv(p, row, C_GT + head * 3 + 1)) / l;
  float* op = p.YB + row * 2048 + head * 128 + vq * 32;
#pragma unroll
  for (int d = 0; d < 32; ++d) op[d] += o[d] * inv;
}

DEVI void st_win_attn(const Params& p, long g) {
  int vq = (int)(g & 3); long r = g >> 2;
  int t = (int)(r % T_); int head = (int)((r / T_) % 16); int b = (int)(r / ((long)T_ * 16));
  int gg = head >> 2;
  long row = (long)b * T_ + t;
  const float scale = 0.08838834764831845f;
  const float slope = alibi_slope(head);
  float q[128];
#pragma unroll
  for (int d = 0; d < 128; ++d) q[d] = pbv(p, row, C_BQ + head * 128 + d) * scale;
  float o[32];
#pragma unroll
  for (int d = 0; d < 32; ++d) o[d] = 0.f;
  float mx = -3.0e38f, l = 0.f;
  int k0 = t - 511; if (k0 < 0) k0 = 0;
  for (int kp = k0; kp <= t; ++kp) {
    const bf16_t* pk = p.PB + ((long)b * T_ + kp) * PB_W - PA_W;
    const bf16_t* kr = pk + C_KW + gg * 128;
    const bf16_t* vr = pk + C_VW + gg * 128 + vq * 32;
    float s = 0.f;
#pragma unroll
    for (int d = 0; d < 128; ++d) s += q[d] * bf2f(kr[d]);
    s -= slope * (float)(t - kp);
    if (s > mx) {
      float a = expf(mx - s);
      l *= a;
#pragma unroll
      for (int d = 0; d < 32; ++d) o[d] *= a;
      mx = s;
    }
    float pp = expf(s - mx);
    l += pp;
#pragma unroll
    for (int d = 0; d < 32; ++d) o[d] += pp * bf2f(vr[d]);
  }
  float inv = sigmoidf_(pbv(p, row, C_GT + head * 3 + 2)) / l;
  float* op = p.YB + row * 2048 + head * 128 + vq * 32;
#pragma unroll
  for (int d = 0; d < 32; ++d) {
    int c = head * 128 + vq * 32 + d;
    float y = (op[d] + o[d] * inv) * siluf_(pbv(p, row, C_BG + c));
    p.Ymix[row * 4096 + 2048 + c] = f2bf(y);
  }
}


DEVI void st_wg(const Params& p, long g) {
  int d = (int)(g & 255); long r = g >> 8;
  int rr = (int)(r & 255); r >>= 8;
  int half = (int)(r & 1); r >>= 1;
  int n = (int)(r % 10); int o = (int)(r / 10);
  int e = half * 128 + (rr & 127);
  const float* w = (rr < 128 ? p.rg_w_a : p.rg_w_i) + ((long)o * 10 + n) * 65536;
  p.Wt_g[g] = f2bf(w[d * 256 + e]);
  if (g < 2 * DR) p.SP[g] = -8.0f * softplusf_(-p.rg_lambda[g]);
  if (g < 2048) { p.LB[g] = 0.f; p.LB[2048 + g] = sigmoidf_(p.hgrn_lb_logits[2048 + g] - p.hgrn_lb_logits[g]); }
}


DEVI void st_scan1(const Params& p, long g) {
  int cp = (int)(g % 1280); int r = (int)(g / 1280);
  int ch = r & 31, b = r >> 5;
  long base = ((long)b * T_ + ch * 64) * DR + 2 * cp;
  float h0 = 0.f, h1 = 0.f, s0 = 0.f, s1 = 0.f;
#pragma unroll 16
  for (int i = 0; i < 64; ++i) {
    const unsigned la = *(const unsigned*)(p.LA + base + (long)i * DR), uu = *(const unsigned*)(p.UB + base + (long)i * DR);
    const float l0 = u_as_f(la << 16), l1 = u_as_f(la & 0xFFFF0000u);
    h0 = expf(l0) * h0 + u_as_f(uu << 16); h1 = expf(l1) * h1 + u_as_f(uu & 0xFFFF0000u);
    s0 += l0; s1 += l1;
  }
  long so = ((long)b * 32 + ch) * DR + 2 * cp;
  p.SUMP[so] = expf(s0); p.SUMP[so + 1] = expf(s1);
  p.SUMH[so] = h0; p.SUMH[so + 1] = h1;
}
DEVI void st_scan2(const Params& p, long g) {
  int cp = (int)(g % 1280); int r = (int)(g / 1280);
  int ch = r & 31, b = r >> 5;
  float h0 = 0.f, h1 = 0.f;
  for (int cc = 0; cc < ch; ++cc) {
    long so = ((long)b * 32 + cc) * DR + 2 * cp;
    h0 = p.SUMP[so] * h0 + p.SUMH[so]; h1 = p.SUMP[so + 1] * h1 + p.SUMH[so + 1];
  }
  long base = ((long)b * T_ + ch * 64) * DR + 2 * cp;
#pragma unroll 16
  for (int i = 0; i < 64; ++i) {
    const unsigned la = *(const unsigned*)(p.LA + base + (long)i * DR), uu = *(const unsigned*)(p.UB + base + (long)i * DR);
    const unsigned gs = *(const unsigned*)(p.GS + base + (long)i * DR);
    h0 = expf(u_as_f(la << 16)) * h0 + u_as_f(uu << 16); h1 = expf(u_as_f(la & 0xFFFF0000u)) * h1 + u_as_f(uu & 0xFFFF0000u);
    const float y0 = h0 * u_as_f(gs << 16), y1 = h1 * u_as_f(gs & 0xFFFF0000u);
    *(unsigned*)(p.Ymix + base + (long)i * DR) = (unsigned)f2bf(y0) | ((unsigned)f2bf(y1) << 16);
  }
}

#ifndef CPU_SHIM
#if defined(__HIP_DEVICE_COMPILE__)
typedef const __attribute__((address_space(4))) Params* KParamsPtr;
__device__ __forceinline__ KParamsPtr kparams() {
  KParamsPtr kp = (KParamsPtr)__builtin_amdgcn_kernarg_segment_ptr();
  asm volatile("" : "+s"(kp));
  return kp;
}
__device__ __forceinline__ int opaque_lane() {
  int l;
  asm volatile("v_mbcnt_lo_u32_b32 %0, -1, 0\n\tv_mbcnt_hi_u32_b32 %0, -1, %0" : "=v"(l));
  return l;
}
#define opaque_tid() (wid_s * 64 + opaque_lane())
#else
__device__ __forceinline__ const Params* kparams() { return nullptr; }
__device__ __forceinline__ int opaque_lane() { return 0; }
#define opaque_tid() (wid_s * 64 + opaque_lane())
#endif
namespace pg8 {
#define PG8_LAS __attribute__((address_space(3)))
typedef short bf16x8 __attribute__((ext_vector_type(8)));
typedef float f32x4 __attribute__((ext_vector_type(4)));
typedef unsigned u32x4 __attribute__((ext_vector_type(4)));
constexpr int BM = 256, BK = 64, HALF = 128, HTB = HALF * BK * 2  , STAGE_BYTES = 8 * HTB, NXCD = 8, WGM = 8;

__host__ __device__ __forceinline__ int lds_byte(int r, int c) { const int st = (r >> 4) * 2 + (c >> 5), rr = r & 15, cc = c & 31, ob = rr * 64 + cc * 2; return st * 1024 + (ob ^ (((ob >> 9) & 1) << 5)); }
__host__ __device__ __forceinline__ void stage_rc(int b, int& R, int& C) { const int st = b / 1024, sb = b % 1024, swz = sb ^ (((sb >> 9) & 1) << 5); R = (st >> 1) * 16 + swz / 64; C = (st & 1) * 32 + (swz % 64) / 2; }
__host__ __device__ __forceinline__ int perm32(int rho) { const int n = rho >> 4, i = rho & 15; return 8 * (i >> 2) + 4 * n + (i & 3); }

struct Unit { int pm, pn; };
struct Gemm { const bf16_t* A; const bf16_t* Bt; int M, N, K; };
struct StaticOrder {
    int nM, nN, nwg, G, c;
    __host__ __device__ void init(int M, int N, int G_, int c_) { nM = M / BM; nN = N / BM; nwg = nM * nN; G = G_; c = c_; }
    __host__ __device__ bool next(int i, Unit& u) const {
        const long L = (long)i * G + c; if (L >= nwg) return false;
        int wgid = (int)L; { const int q = nwg / NXCD, r = nwg % NXCD, xcd = wgid % NXCD, off = wgid / NXCD; wgid = (xcd < r ? xcd * (q + 1) : r * (q + 1) + (xcd - r) * q) + off; }
        const int nig = WGM * nN, gid = wgid / nig, fm = gid * WGM, gsz = (nM - fm) < WGM ? (nM - fm) : WGM;
        u.pm = fm + ((wgid % nig) % gsz); u.pn = (wgid % nig) / gsz; return true;
    }
    __device__ __forceinline__ void a_ready(const Unit&) const {}
    __device__ __forceinline__ void done(const Unit&) const {}
};
typedef float f32x2_t __attribute__((ext_vector_type(2))); typedef __bf16 bf16x2_t __attribute__((ext_vector_type(2)));
__device__ __forceinline__ unsigned cvt_pk_bf16(float lo, float hi) { f32x2_t v = {lo, hi}; bf16x2_t b = __builtin_convertvector(v, bf16x2_t); return __builtin_bit_cast(unsigned, b); }

template <class Epi, class Sched, bool ALIGN_EPI = false, bool SP2 = false>
__device__ __forceinline__ void gemm_phase(PG8_LAS unsigned char* lds, const Gemm g, const Sched& S, const Epi& E, const int wid_s) {
    const int tid = opaque_tid(), wid = wid_s, lane = tid & 63, wr = wid >> 2, wc = wid & 3, fr = lane & 15, fq = lane >> 4;
    const int K = g.K, nt = K / BK;
    unsigned voffA[2], voffB[2];
#pragma unroll
    for (int i = 0; i < 2; ++i) { int R, C; stage_rc(tid * 16 + i * 8192, R, C); const int Rb = Epi::PERM ? ((R & ~31) + perm32(R & 31)) : R;
        voffA[i] = (unsigned)(R * K + C) * 2u; voffB[i] = (unsigned)(Rb * K + C) * 2u; }
    const size_t kstep = (size_t)(BK * 2);
    const size_t hstep = (size_t)HALF * K * 2;
    const size_t tstep = 2 * hstep;
    const unsigned ldsw = (unsigned)wid * 1024u;
    const int aoff = lds_byte(wr * 64 + fr, fq * 8), boff = lds_byte(wc * 32 + fr, fq * 8);
#define PG8_SA(b, h) (((b) * 2 + (h)) * HTB)
#define PG8_SB(b, h) ((4 + (b) * 2 + (h)) * HTB)
#define PG8_STAGE(bufoff, gbase, voff) do { _Pragma("unroll") for (int _i = 0; _i < 2; ++_i) \
        __builtin_amdgcn_global_load_lds((const unsigned*)((const char*)(gbase) + (voff)[_i]), (PG8_LAS unsigned*)(lds + (bufoff) + ldsw + _i * 8192), 16, 0, 0); } while (0)
#define PG8_LDA(dst, b, h) do { _Pragma("unroll") for (int m = 0; m < 4; ++m) _Pragma("unroll") for (int k = 0; k < 2; ++k) dst[m][k] = *(const PG8_LAS bf16x8*)(lds + PG8_SA(b, h) + aoff + m * 2048 + k * 1024); } while (0)
#define PG8_LDB(dst, b, h) do { _Pragma("unroll") for (int n = 0; n < 2; ++n) _Pragma("unroll") for (int k = 0; k < 2; ++k) dst[n][k] = *(const PG8_LAS bf16x8*)(lds + PG8_SB(b, h) + boff + n * 2048 + k * 1024); } while (0)
#define PG8_MMA(ai, bj, At, Bt) do { __builtin_amdgcn_s_setprio(1); _Pragma("unroll") for (int m = 0; m < 4; ++m) _Pragma("unroll") for (int n = 0; n < 2; ++n) _Pragma("unroll") for (int k = 0; k < 2; ++k) \
        acc[ai][bj][m][n] = __builtin_amdgcn_mfma_f32_16x16x32_bf16(Bt[n][k], At[m][k], acc[ai][bj][m][n], 0, 0, 0); __builtin_amdgcn_s_setprio(0); } while (0)
#define PG8_WAIT_V(n) asm volatile("s_waitcnt vmcnt(" #n ")" ::: "memory")
#define PG8_WAIT_L(n) asm volatile("s_waitcnt lgkmcnt(" #n ")" ::: "memory")
#define PG8_BAR __builtin_amdgcn_s_barrier()
#define PG8_SCHED __builtin_amdgcn_sched_barrier(0)
    Unit cur, nxt; int ui = 0;
    if (!S.next(0, cur)) return;
    f32x4 acc[2][2][4][2];
#pragma unroll
    for (int a = 0; a < 2; ++a)
#pragma unroll
        for (int b = 0; b < 2; ++b)
#pragma unroll
            for (int m = 0; m < 4; ++m)
#pragma unroll
                for (int n = 0; n < 2; ++n) acc[a][b][m][n] = (f32x4){0.f, 0.f, 0.f, 0.f};
    bf16x8 At[4][2], B0[2][2], B1[2][2];
    const char* cA = (const char*)g.A + (size_t)cur.pm * tstep; const char* cB = (const char*)g.Bt + (size_t)cur.pn * tstep;
    S.a_ready(cur);
    if constexpr (SP2) {
        PG8_STAGE(PG8_SB(0, 0), cB, voffB); PG8_STAGE(PG8_SB(0, 1), cB + hstep, voffB); PG8_STAGE(PG8_SA(0, 0), cA, voffA); PG8_STAGE(PG8_SA(0, 1), cA + hstep, voffA);
        if (wr == 1) PG8_BAR;
        PG8_WAIT_V(2); PG8_BAR;
        PG8_STAGE(PG8_SB(1, 0), cB + kstep, voffB); PG8_STAGE(PG8_SA(1, 0), cA + kstep, voffA); PG8_STAGE(PG8_SB(1, 1), cB + hstep + kstep, voffB);
        PG8_WAIT_V(6); PG8_BAR;
    } else {
        PG8_STAGE(PG8_SB(0, 0), cB, voffB); PG8_STAGE(PG8_SA(0, 0), cA, voffA); PG8_STAGE(PG8_SB(0, 1), cB + hstep, voffB); PG8_STAGE(PG8_SA(0, 1), cA + hstep, voffA);
        if (wr == 1) PG8_BAR;
        PG8_WAIT_V(4); PG8_BAR;
        PG8_STAGE(PG8_SB(1, 0), cB + kstep, voffB); PG8_STAGE(PG8_SA(1, 0), cA + kstep, voffA); PG8_STAGE(PG8_SB(1, 1), cB + hstep + kstep, voffB);
        PG8_WAIT_V(6); PG8_BAR;
    }
    for (;;) {
        const bool has_next = S.next(ui + 1, nxt);
        const char* nA = has_next ? (const char*)g.A + (size_t)nxt.pm * tstep : cA; const char* nB = has_next ? (const char*)g.Bt + (size_t)nxt.pn * tstep : cB;
        for (int t = 0; t < nt; t += 2) {
            const bool last = (t == nt - 2);
            const char* a1 = cA + (size_t)(t + 1) * kstep;
            const char* a2 = last ? nA : cA + (size_t)(t + 2) * kstep; const char* b2 = last ? nB : cB + (size_t)(t + 2) * kstep;
            const char* a3 = a2 + kstep; const char* b3 = b2 + kstep;
            if (last && has_next) S.a_ready(nxt);
            if constexpr (SP2) {
            PG8_LDB(B0, 0, 0); PG8_LDB(B1, 0, 1); PG8_SCHED; PG8_LDA(At, 0, 0); PG8_STAGE(PG8_SA(1, 1), a1 + hstep, voffA);
            PG8_WAIT_V(8); PG8_WAIT_L(0); PG8_BAR; PG8_MMA(0, 0, At, B0); PG8_MMA(0, 1, At, B1); PG8_BAR; PG8_SCHED;
            PG8_LDA(At, 0, 1); PG8_STAGE(PG8_SB(0, 0), b2, voffB); PG8_STAGE(PG8_SB(0, 1), b2 + hstep, voffB); PG8_STAGE(PG8_SA(0, 0), a2, voffA);
            PG8_WAIT_V(8); PG8_WAIT_L(0); PG8_BAR; PG8_MMA(1, 0, At, B0); PG8_MMA(1, 1, At, B1); PG8_BAR; PG8_SCHED;
            PG8_LDB(B0, 1, 0); PG8_LDB(B1, 1, 1); PG8_SCHED; PG8_LDA(At, 1, 0); PG8_STAGE(PG8_SA(0, 1), a2 + hstep, voffA);
            PG8_WAIT_V(8); PG8_WAIT_L(0); PG8_BAR; PG8_MMA(0, 0, At, B0); PG8_MMA(0, 1, At, B1); PG8_BAR; PG8_SCHED;
            PG8_LDA(At, 1, 1); PG8_STAGE(PG8_SB(1, 0), b3, voffB); PG8_STAGE(PG8_SB(1, 1), b3 + hstep, voffB); PG8_STAGE(PG8_SA(1, 0), a3, voffA);
            PG8_WAIT_V(8); PG8_WAIT_L(0); PG8_BAR; PG8_MMA(1, 0, At, B0); PG8_MMA(1, 1, At, B1); PG8_BAR; PG8_SCHED;
            } else {
            PG8_LDB(B0, 0, 0); PG8_SCHED; PG8_LDA(At, 0, 0); PG8_STAGE(PG8_SA(1, 1), a1 + hstep, voffA);
            PG8_WAIT_L(8); PG8_BAR; PG8_WAIT_L(0); PG8_MMA(0, 0, At, B0); PG8_BAR; PG8_SCHED;
            PG8_LDB(B1, 0, 1); PG8_STAGE(PG8_SB(0, 0), b2, voffB);
            PG8_BAR; PG8_WAIT_L(0); PG8_MMA(0, 1, At, B1); PG8_BAR;
            PG8_LDA(At, 0, 1); PG8_STAGE(PG8_SA(0, 0), a2, voffA);
            PG8_BAR; PG8_WAIT_L(0); PG8_MMA(1, 0, At, B0); PG8_BAR; PG8_SCHED;
            PG8_STAGE(PG8_SB(0, 1), b2 + hstep, voffB);
            PG8_WAIT_V(6); PG8_BAR; PG8_MMA(1, 1, At, B1); PG8_BAR;
            PG8_LDB(B0, 1, 0); PG8_SCHED; PG8_LDA(At, 1, 0); PG8_STAGE(PG8_SA(0, 1), a2 + hstep, voffA);
            PG8_WAIT_L(8); PG8_BAR; PG8_WAIT_L(0); PG8_MMA(0, 0, At, B0); PG8_BAR; PG8_SCHED;
            PG8_LDB(B1, 1, 1); PG8_STAGE(PG8_SB(1, 0), b3, voffB);
            PG8_BAR; PG8_WAIT_L(0); PG8_MMA(0, 1, At, B1); PG8_BAR;
            PG8_LDA(At, 1, 1); PG8_STAGE(PG8_SA(1, 0), a3, voffA);
            PG8_BAR; PG8_WAIT_L(0); PG8_MMA(1, 0, At, B0); PG8_BAR; PG8_SCHED;
            PG8_STAGE(PG8_SB(1, 1), b3 + hstep, voffB);
            PG8_WAIT_V(6); PG8_BAR; PG8_MMA(1, 1, At, B1); PG8_BAR;
            }
        }
        if constexpr (ALIGN_EPI) { if (wr == 0) PG8_BAR; }
        if constexpr (!Epi::AFTER_DRAIN) { E(acc, cur, wr, wc, fr, fq); S.done(cur); }
        if (!has_next) break;
#pragma unroll
        for (int a = 0; a < 2; ++a)
#pragma unroll
            for (int b = 0; b < 2; ++b)
#pragma unroll
                for (int m = 0; m < 4; ++m)
#pragma unroll
                    for (int n = 0; n < 2; ++n) acc[a][b][m][n] = (f32x4){0.f, 0.f, 0.f, 0.f};
        cur = nxt; cA = nA; cB = nB; ++ui;
        if constexpr (ALIGN_EPI) { if (wr == 1) PG8_BAR; }
    }
    PG8_WAIT_V(0);
    if constexpr (!ALIGN_EPI) { if (wr == 0) PG8_BAR; }
    PG8_BAR;
    if constexpr (Epi::AFTER_DRAIN) { E.fused(acc, cur, wr, wc, fr, fq, lds, wid, lane); S.done(cur); }
#undef PG8_SA
#undef PG8_SB
#undef PG8_STAGE
#undef PG8_LDA
#undef PG8_LDB
#undef PG8_MMA
#undef PG8_WAIT_V
#undef PG8_WAIT_L
#undef PG8_BAR
#undef PG8_SCHED
}
}

#define LAS __attribute__((address_space(3)))
using pg8::f32x4;
using pg8::bf16x8;

struct EpiStoreF32 {
  static constexpr bool PERM = false, AFTER_DRAIN = false;
  float* C; int ldc;
  __device__ __forceinline__ void operator()(const f32x4 (&acc)[2][2][4][2], const pg8::Unit& u, int wr, int wc, int fr, int fq) const {
    const int row0 = u.pm * 256 + wr * 64 + fr, col0 = u.pn * 256 + wc * 32 + 4 * fq;
#pragma unroll
    for (int ai = 0; ai < 2; ++ai)
#pragma unroll
      for (int m = 0; m < 4; ++m) {
        float* rowp = C + (size_t)(row0 + ai * 128 + m * 16) * ldc + col0;
#pragma unroll
        for (int bj = 0; bj < 2; ++bj)
#pragma unroll
          for (int n = 0; n < 2; ++n) *(f32x4*)(rowp + bj * 128 + n * 16) = acc[ai][bj][m][n];
      }
  }
};
struct EpiAccumF32 {
  static constexpr bool PERM = false, AFTER_DRAIN = false;
  float* C; int ldc;
  __device__ __forceinline__ void operator()(const f32x4 (&acc)[2][2][4][2], const pg8::Unit& u, int wr, int wc, int fr, int fq) const {
    const int row0 = u.pm * 256 + wr * 64 + fr, col0 = u.pn * 256 + wc * 32 + 4 * fq;
#pragma unroll
    for (int ai = 0; ai < 2; ++ai) {
      f32x4 cv[4][2][2];
#pragma unroll
      for (int m = 0; m < 4; ++m) {
        const float* rowp = C + (size_t)(row0 + ai * 128 + m * 16) * ldc + col0;
#pragma unroll
        for (int bj = 0; bj < 2; ++bj)
#pragma unroll
          for (int n = 0; n < 2; ++n) cv[m][bj][n] = *(const f32x4*)(rowp + bj * 128 + n * 16);
      }
#pragma unroll
      for (int m = 0; m < 4; ++m) {
        float* rowp = C + (size_t)(row0 + ai * 128 + m * 16) * ldc + col0;
#pragma unroll
        for (int bj = 0; bj < 2; ++bj)
#pragma unroll
          for (int n = 0; n < 2; ++n) *(f32x4*)(rowp + bj * 128 + n * 16) = cv[m][bj][n] + acc[ai][bj][m][n];
      }
    }
  }
};
__device__ __forceinline__ float fexp_(float x) { return __builtin_amdgcn_exp2f(x * 1.4426950408889634f); }
__device__ __forceinline__ float fsigmoid_(float x) { return __builtin_amdgcn_rcpf(1.0f + fexp_(-x)); }
__device__ __forceinline__ float fsilu_(float x) { return x * fsigmoid_(x); }
__device__ __forceinline__ float one_minus_exp_(float x) {
  const float big = 1.0f - fexp_(x);
  const float small = -x * (1.0f + x * (0.5f + x * (0.16666667f + x * 0.041666668f)));
  return x > -0.125f ? small : big;
}


struct EpiEvenIn {
  static constexpr bool PERM = false, AFTER_DRAIN = false;
  bf16_t* QS; float* LF; bf16_t* KK; bf16_t* AVT; const float* LB; bf16_t* PB; bf16_t* VT; bf16_t* KVC;
  __device__ __forceinline__ void operator()(const f32x4 (&acc)[2][2][4][2], const pg8::Unit& u, int wr, int wc, int fr, int fq) const {
    const int row0 = u.pm * 256 + wr * 64 + fr, col0 = u.pn * 256 + wc * 32 + 4 * fq;
    const int pn = u.pn;
    f32x4 lbv[2][2];
    if (pn >= 8 && pn < 16) {
#pragma unroll
      for (int bj = 0; bj < 2; ++bj)
#pragma unroll
        for (int n = 0; n < 2; ++n) lbv[bj][n] = *(const f32x4*)(LB + (col0 + bj * 128 + n * 16 - 2048));
#pragma unroll
      for (int bj = 0; bj < 2; ++bj)
#pragma unroll
        for (int n = 0; n < 2; ++n) asm volatile("" : "+v"(lbv[bj][n]));
    }
#pragma unroll
    for (int ai = 0; ai < 2; ++ai)
#pragma unroll
      for (int m = 0; m < 4; ++m) {
        const long row = row0 + ai * 128 + m * 16;
#pragma unroll
        for (int bj = 0; bj < 2; ++bj)
#pragma unroll
          for (int n = 0; n < 2; ++n) {
            const f32x4 v = acc[ai][bj][m][n];
            const int col = col0 + bj * 128 + n * 16;
            if (pn < 8) {
              uint2 w; w.x = pg8::cvt_pk_bf16(fsilu_(v[0]), fsilu_(v[1])); w.y = pg8::cvt_pk_bf16(fsilu_(v[2]), fsilu_(v[3]));
              *(uint2*)(QS + row * 2048 + col) = w;
            } else if (pn < 16) {
              const int c = col - 2048;
              const f32x4 lb = lbv[bj][n];
              f32x4 lf; float kk[4];
#pragma unroll
              for (int i = 0; i < 4; ++i) {
                const float sg = fsigmoid_(v[i]);
                const float f = lb[i] + (1.0f - lb[i]) * sg;
                lf[i] = __builtin_amdgcn_logf(fmaxf(f, 1e-30f)) * 0.6931471805599453f;
                kk[i] = (1.0f - lb[i]) * fsigmoid_(-v[i]);
              }
              *(f32x4*)(LF + row * 2048 + c) = lf;
              uint2 w; w.x = pg8::cvt_pk_bf16(kk[0], kk[1]); w.y = pg8::cvt_pk_bf16(kk[2], kk[3]);
              *(uint2*)(KK + row * 2048 + c) = w;
            } else if (pn < 24) {
              const int c = col - 4096;
              const long bb = row >> 11; const int t = (int)(row & 2047);
              bf16_t* dst = AVT + ((bb * 2048) + c) * T_ + t;
#pragma unroll
              for (int i = 0; i < 4; ++i) dst[(long)i * T_] = f2bf(v[i]);
            } else if (pn == 46 || pn == 47 || pn == 50 || pn == 51) {
              const int which = pn >= 50;
              const int c = col - (which ? C_VW : C_VS);
              const long bb = row >> 11; const int t = (int)(row & 2047);
              bf16_t* dst = VT + (((long)which * NB + bb) * 512 + c) * T_ + t;
#pragma unroll
              for (int i = 0; i < 4; ++i) dst[(long)i * T_] = f2bf(v[i]);
            } else if (pn >= 40 && pn < 44) {
              const int kv = pn >= 42;
              const int c = col - (kv ? C_VC : C_KC);
              const long bb = row >> 11; const int t = (int)(row & 2047);
              uint2 w; w.x = pg8::cvt_pk_bf16(v[0], v[1]); w.y = pg8::cvt_pk_bf16(v[2], v[3]);
              *(uint2*)(KVC + ((((long)kv * NB + bb) * 4 + (c >> 7)) * T_ + t) * 128 + (c & 127)) = w;
            } else {
              uint2 w; w.x = pg8::cvt_pk_bf16(v[0], v[1]); w.y = pg8::cvt_pk_bf16(v[2], v[3]);
              *(uint2*)(PB + row * PB_W + (col - PA_W)) = w;
            }
          }
      }
  }
};

struct DiagOrder {
  int G, c;
  __device__ bool next(int i, pg8::Unit& u) const {
    const int L = i * G + c; if (L >= 640) return false;
    const int n = L >> 6, rem = L & 63;
    u.pm = n * 32 + (rem & 31); u.pn = n * 2 + (rem >> 5); return true;
  }
  __device__ __forceinline__ void a_ready(const pg8::Unit&) const {}
  __device__ __forceinline__ void done(const pg8::Unit&) const {}
};
struct CmpOrder {
  int G, c;
  __device__ bool next(int i, pg8::Unit& u) const {
    const int L = i * G + c; if (L >= 16) return false;
    u.pm = L; u.pn = L >> 3; return true;
  }
  __device__ __forceinline__ void a_ready(const pg8::Unit&) const {}
  __device__ __forceinline__ void done(const pg8::Unit&) const {}
};
struct EpiZ {
  static constexpr bool PERM = false, AFTER_DRAIN = false;
  float* C;
  __device__ __forceinline__ void operator()(const f32x4 (&acc)[2][2][4][2], const pg8::Unit& u, int wr, int wc, int fr, int fq) const {
    const int row0 = u.pm * 256 + wr * 64 + fr, col0 = wc * 32 + 4 * fq;
#pragma unroll
    for (int ai = 0; ai < 2; ++ai)
#pragma unroll
      for (int m = 0; m < 4; ++m) {
        float* rowp = C + (size_t)(row0 + ai * 128 + m * 16) * 256 + col0;
#pragma unroll
        for (int bj = 0; bj < 2; ++bj)
#pragma unroll
          for (int n = 0; n < 2; ++n) *(f32x4*)(rowp + bj * 128 + n * 16) = acc[ai][bj][m][n];
      }
  }
};
struct EpiGates {
  static constexpr bool PERM = false, AFTER_DRAIN = false;
  const bf16_t* XCb; const float* b_a; const float* b_i; const float* lam; bf16_t* LA; bf16_t* UB;
  __device__ __forceinline__ void operator()(const f32x4 (&acc)[2][2][4][2], const pg8::Unit& u, int wr, int wc, int fr, int fq) const {
    const int n = u.pn >> 1, half = u.pn & 1;
    const int row0 = (u.pm & 31) * 256 + wr * 64 + fr;
    const int el0 = 128 * half + 32 * wc + 4 * fq;
    f32x4 bav[2], biv[2], spv[2]; uint2 xwv[2][2][4];
#pragma unroll
    for (int nn = 0; nn < 2; ++nn) {
      const int el = el0 + 16 * nn, c = n * 256 + el;
      bav[nn] = *(const f32x4*)(b_a + c); biv[nn] = *(const f32x4*)(b_i + c); spv[nn] = *(const f32x4*)(lam + c);
#pragma unroll
      for (int ai = 0; ai < 2; ++ai)
#pragma unroll
        for (int m = 0; m < 4; ++m) xwv[nn][ai][m] = *(const uint2*)(XCb + ((long)n * M_ + (row0 + ai * 128 + m * 16)) * 256 + el);
    }
#pragma unroll
    for (int nn = 0; nn < 2; ++nn) {
      asm volatile("" : "+v"(bav[nn])); asm volatile("" : "+v"(biv[nn])); asm volatile("" : "+v"(spv[nn]));
#pragma unroll
      for (int ai = 0; ai < 2; ++ai)
#pragma unroll
        for (int m = 0; m < 4; ++m) asm volatile("" : "+v"(xwv[nn][ai][m]));
    }
#pragma unroll
    for (int nn = 0; nn < 2; ++nn) {
      const int el = el0 + 16 * nn, c = n * 256 + el;
      const f32x4 ba = bav[nn], bi = biv[nn], sp = spv[nn];
#pragma unroll
      for (int ai = 0; ai < 2; ++ai)
#pragma unroll
        for (int m = 0; m < 4; ++m) {
          const long row = row0 + ai * 128 + m * 16;
          const uint2 xw = xwv[nn][ai][m];
          const float xc[4] = {u_as_f(xw.x << 16), u_as_f(xw.x & 0xFFFF0000u), u_as_f(xw.y << 16), u_as_f(xw.y & 0xFFFF0000u)};
          float la[4], uv[4];
#pragma unroll
          for (int i = 0; i < 4; ++i) {
            const float r = fsigmoid_(acc[ai][0][m][nn][i] + ba[i]);
            const float ig = fsigmoid_(acc[ai][1][m][nn][i] + bi[i]);
            la[i] = sp[i] * r;
            uv[i] = __builtin_amdgcn_sqrtf(fmaxf(one_minus_exp_(2.0f * la[i]), 0.f)) * (ig * xc[i]);
          }
          uint2 wl, wu;
          wl.x = pg8::cvt_pk_bf16(la[0], la[1]); wl.y = pg8::cvt_pk_bf16(la[2], la[3]);
          wu.x = pg8::cvt_pk_bf16(uv[0], uv[1]); wu.y = pg8::cvt_pk_bf16(uv[2], uv[3]);
          *(uint2*)(LA + row * DR + c) = wl;
          *(uint2*)(UB + row * DR + c) = wu;
        }
    }
  }
};
struct EpiOddIn {
  static constexpr bool PERM = false, AFTER_DRAIN = false;
  bf16_t* XB; bf16_t* GS;
  __device__ __forceinline__ void operator()(const f32x4 (&acc)[2][2][4][2], const pg8::Unit& u, int wr, int wc, int fr, int fq) const {
    const int row0 = u.pm * 256 + wr * 64 + fr, col0 = u.pn * 256 + wc * 32 + 4 * fq;
    const bool gate = u.pn >= 10;
    bf16_t* dst = gate ? GS - DR : XB;
#pragma unroll
    for (int ai = 0; ai < 2; ++ai)
#pragma unroll
      for (int m = 0; m < 4; ++m) {
        bf16_t* rowp = dst + (size_t)(row0 + ai * 128 + m * 16) * DR + col0;
#pragma unroll
        for (int bj = 0; bj < 2; ++bj)
#pragma unroll
          for (int n = 0; n < 2; ++n) {
            f32x4 v = acc[ai][bj][m][n];
            if (gate) { v[0] = fsilu_(v[0]); v[1] = fsilu_(v[1]); v[2] = fsilu_(v[2]); v[3] = fsilu_(v[3]); }
            uint2 w; w.x = pg8::cvt_pk_bf16(v[0], v[1]); w.y = pg8::cvt_pk_bf16(v[2], v[3]);
            *(uint2*)(rowp + bj * 128 + n * 16) = w;
          }
      }
  }
};

__device__ void wt_convert(const float* __restrict__ W, bf16_t* __restrict__ Wt, int K, int N, int Npad, float* tile  , int bid, int nblk, int tid) {
  const int tk = K / 64, tn = Npad / 64;
  for (int t = bid; t < tk * tn; t += nblk) {
    const int k0 = (t % tk) * 64, n0 = (t / tk) * 64;
    {
      const int r = tid >> 4, c4 = (tid & 15) * 4;
#pragma unroll
      for (int i = 0; i < 2; ++i) {
        const int rr = r + 32 * i;
        float4 v = make_float4(0.f, 0.f, 0.f, 0.f);
        if (n0 + c4 < N) v = *(const float4*)(W + (size_t)(k0 + rr) * N + n0 + c4);
        tile[rr * 65 + c4 + 0] = v.x; tile[rr * 65 + c4 + 1] = v.y; tile[rr * 65 + c4 + 2] = v.z; tile[rr * 65 + c4 + 3] = v.w;
      }
    }
    __syncthreads();
    {
      const int n = tid >> 3, kq = (tid & 7) * 8;
      unsigned w[4];
#pragma unroll
      for (int j = 0; j < 4; ++j)
        w[j] = (unsigned)f2bf(tile[(kq + 2 * j) * 65 + n]) | ((unsigned)f2bf(tile[(kq + 2 * j + 1) * 65 + n]) << 16);
      *(uint4*)(Wt + (size_t)(n0 + n) * K + k0 + kq) = make_uint4(w[0], w[1], w[2], w[3]);
    }
    __syncthreads();
  }
}

__device__ void wt_convert256(const float* __restrict__ W, bf16_t* __restrict__ Wt, int K, int N, int Npad, float* tile  , int bid, int nblk, int tid) {
  const int tk = K / 64, tn = Npad / 256;
  for (int t = bid; t < tk * tn; t += nblk) {
    const int k0 = (t % tk) * 64, n0 = (t / tk) * 256;
    {
      const int r = tid >> 6, c4 = (tid & 63) * 4;
      float4 v[8];
#pragma unroll
      for (int i = 0; i < 8; ++i) {
        v[i] = make_float4(0.f, 0.f, 0.f, 0.f);
        if (n0 + c4 < N) v[i] = *(const float4*)(W + (size_t)(k0 + r + 8 * i) * N + n0 + c4);
      }
#pragma unroll
      for (int i = 0; i < 8; ++i) {
        float* d = tile + (r + 8 * i) * 257 + c4;
        d[0] = v[i].x; d[1] = v[i].y; d[2] = v[i].z; d[3] = v[i].w;
      }
    }
    __syncthreads();
#pragma unroll
    for (int i = 0; i < 4; ++i) {
      const int c = tid + 512 * i, n = c >> 3, kq = (c & 7) * 8;
      unsigned w[4];
#pragma unroll
      for (int j = 0; j < 4; ++j)
        w[j] = (unsigned)f2bf(tile[(kq + 2 * j) * 257 + n]) | ((unsigned)f2bf(tile[(kq + 2 * j + 1) * 257 + n]) << 16);
      *(uint4*)(Wt + (size_t)(n0 + n) * K + k0 + kq) = make_uint4(w[0], w[1], w[2], w[3]);
    }
    __syncthreads();
  }
}
#endif

enum StageKind {
  SK_WT, SK_COPY, SK_ROWSS, SK_NORM, SK_GEMM_EIN, SK_HGRN_PREP, SK_HGRN_REC, SK_HGRN_POST, SK_CMP_HID, SK_CMP_OUT,
  SK_CMP_ATTN, SK_IMP, SK_TOPK, SK_SEL_ATTN, SK_WIN_ATTN, SK_GEMM_EOUT, SK_GEMM_OIN, SK_CONV, SK_GATES,
  SK_SCAN, SK_GEMM_OOUT, SK_FINAL, SK_VT, SK_CONVB, SK_WG, SK_SCAN1, SK_SCAN2, SK_CMP_HID2, SK_CMP_HIDOUT
};
constexpr int N_STAGES = 2 + 2 * 14 + 2 * 7 + 2;

DEVI int even_kind(int i) {
  switch (i) {
    case 0: return SK_ROWSS; case 1: return SK_NORM; case 2: return SK_GEMM_EIN; case 3: return SK_HGRN_PREP;
    case 4: return SK_HGRN_REC; case 5: return SK_HGRN_POST; case 6: return SK_CMP_HID; case 7: return SK_CMP_OUT;
    case 8: return SK_CMP_ATTN; case 9: return SK_IMP; case 10: return SK_TOPK; case 11: return SK_SEL_ATTN;
    case 12: return SK_WIN_ATTN; default: return SK_GEMM_EOUT;
  }
}
DEVI int odd_kind(int i) {
  switch (i) {
    case 0: return SK_ROWSS; case 1: return SK_NORM; case 2: return SK_GEMM_OIN; case 3: return SK_CONV;
    case 4: return SK_GATES; case 5: return SK_SCAN; default: return SK_GEMM_OOUT;
  }
}
DEVI void stage_desc(int s, int& kind, int& layer) {
  if (s == 0) { kind = SK_WT; layer = 0; return; }
  if (s == 1) { kind = SK_COPY; layer = 0; return; }
  s -= 2;
  for (int l = 0; l < 4; ++l) {
    int n = (l & 1) ? 7 : 14;
    if (s < n) {
      layer = l;
      kind = (l & 1) ? odd_kind(s) : even_kind(s);
      return;
    }
    s -= n;
  }
  layer = 4;
  kind = s == 0 ? SK_ROWSS : SK_FINAL;
}

DEVI long stage_threads(int kind) {
  switch (kind) {
    case SK_WT: return N_WT;
    case SK_COPY: return (long)M_ * D_;
    case SK_ROWSS: return (long)M_ * 16;
    case SK_NORM: return (long)M_ * D_;
    case SK_HGRN_PREP: return (long)M_ * 2048;
    case SK_HGRN_REC: return (long)NB * 16 * 128;
    case SK_HGRN_POST: return (long)M_ * 16;
    case SK_CMP_HID: return 2L * NB * 4 * NCMP * 128;
    case SK_CMP_OUT: return 2L * NB * 4 * NCMP * 128;
    case SK_CMP_HID2: return 2L * NB * 4 * NCMP * 128;
    case SK_CMP_HIDOUT: return 2L * NB * 4 * NCMP * 128;
    case SK_CMP_ATTN: return (long)NB * 16 * T_;
    case SK_IMP: return (long)M_ * 4 * 32;
    case SK_TOPK: return (long)M_ * 4;
    case SK_SEL_ATTN: return (long)NB * 16 * T_ * 4;
    case SK_WIN_ATTN: return (long)NB * 16 * T_ * 4;
    case SK_CONV: return (long)M_ * DR;
    case SK_GATES: return (long)M_ * DR;
    case SK_SCAN: return (long)NB * DR;
    case SK_FINAL: return (long)M_ * D_;
    case SK_VT: return 2L * NB * 4 * 128 * T_;
    case SK_CONVB: return (long)M_ * DR;
    case SK_WG: return 2L * 10 * 2 * 256 * 256;
    case SK_SCAN1: return (long)NB * 32 * 1280;
    case SK_SCAN2: return (long)NB * 32 * 1280;
    default: return 0;
  }
}

DEVI void stage_thread(const Params& p, int kind, int layer, long g) {
  const int e = layer >> 1;
  switch (kind) {
    case SK_WT: st_wt(p, g); break;
    case SK_COPY: st_copy(p, g); break;
    case SK_ROWSS: st_rowss(p, g); break;
    case SK_NORM: st_norm(p, layer, g); break;
    case SK_HGRN_POST: st_hgrn_post(p, e, g); break;
    case SK_HGRN_REC: st_hgrn_rec2(p, g); break;
    case SK_CMP_HID: st_cmp_hid(p, e, g); break;
    case SK_CMP_OUT: st_cmp_out(p, e, g); break;
    case SK_CMP_HID2: st_cmp_hid2(p, e, g); break;
    case SK_CMP_HIDOUT: st_cmp_hidout(p, e, g); break;
    case SK_CMP_ATTN: st_cmp_attn(p, g); break;
    case SK_IMP: st_imp(p, g); break;
    case SK_TOPK: st_topk(p, g); break;
    case SK_SEL_ATTN: st_sel_attn(p, g); break;
    case SK_WIN_ATTN: st_win_attn(p, g); break;
    case SK_FINAL: st_final(p, g); break;
    case SK_WG: st_wg(p, g); break;
    case SK_SCAN1: st_scan1(p, g); break;
    case SK_SCAN2: st_scan2(p, g); break;
    default: break;
  }
}

#ifndef CPU_SHIM
#ifndef SP2_EIN
#define SP2_EIN true
#endif
#ifndef SP2_OUT
#define SP2_OUT true
#endif
#ifndef SP2_OIN
#define SP2_OIN true
#endif
#ifndef SP2_GATES
#define SP2_GATES false
#endif
#ifndef SP2_CMP
#define SP2_CMP true
#endif
constexpr bool GEMM_ALIGN = true;
constexpr int NTHREADS = 512;
constexpr int NBLK = 256;

using f32x16 = __attribute__((ext_vector_type(16))) float;
using u32x4v = __attribute__((ext_vector_type(4))) unsigned int;
using u32x2v = __attribute__((ext_vector_type(2))) unsigned int;
constexpr int AT_OSTR = 528;
constexpr int AT_KSTR = 272, AT_VSTR = 136, AT_KBYTES = 64 * AT_KSTR, AT_VBYTES = 128 * AT_VSTR, AT_BUF = AT_KBYTES + AT_VBYTES;
constexpr float LOG2E_F = 1.4426950408889634f;

__device__ __forceinline__ bf16x8 scale_bf16x8(bf16x8 v, float sc) {
  u32x4v w = __builtin_bit_cast(u32x4v, v);
  u32x4v o;
#pragma unroll
  for (int i = 0; i < 4; ++i) {
    float lo = u_as_f(w[i] << 16) * sc, hi = u_as_f(w[i] & 0xFFFF0000u) * sc;
    o[i] = pg8::cvt_pk_bf16(lo, hi);
  }
  return __builtin_bit_cast(bf16x8, o);
}
__device__ __forceinline__ float xhalf_max(const float v) {
  auto rr = __builtin_amdgcn_permlane32_swap(__float_as_uint(v), __float_as_uint(v), false, false);
  return fmaxf(__uint_as_float(rr[0]), __uint_as_float(rr[1]));
}
__device__ __forceinline__ float xhalf_sum(const float v) {
  auto rr = __builtin_amdgcn_permlane32_swap(__float_as_uint(v), __float_as_uint(v), false, false);
  return __uint_as_float(rr[0]) + __uint_as_float(rr[1]);
}
__device__ __forceinline__ bf16x8 pack_bf16x8(const f32x16& pv, int base) {
  u32x4v o;
#pragma unroll
  for (int i = 0; i < 4; ++i) o[i] = pg8::cvt_pk_bf16(pv[base + 2 * i], pv[base + 2 * i + 1]);
  return __builtin_bit_cast(bf16x8, o);
}


constexpr int HG_TOT = 0, HG_E1 = 2048, HG_E2 = 2560, HG_QT = 3072, HG_KT = HG_QT + 17408, HG_KTT = HG_KT + 17408,
              HG_VTT = HG_KTT + 18432, HG_SPT = HG_VTT + 4608;

__device__ __forceinline__ void hgrn_phase(const Params& p, LAS unsigned char* lds, const int tid, const int wid) {
  const int lane = tid & 63, l31 = lane & 31, hi = lane >> 5;
  const int item = blockIdx.x;
  const int vs = item & 3, h = (item >> 2) & 15, b = item >> 6;
  const int k = tid & 127, rq = tid >> 7;
  LAS float* TOT = (LAS float*)(lds + HG_TOT);
  LAS float* E1 = (LAS float*)(lds + HG_E1);
  LAS float* E2 = (LAS float*)(lds + HG_E2);
  f32x16 S;
#pragma unroll
  for (int r = 0; r < 16; ++r) S[r] = 0.f;
  float lf[16]; unsigned short qs[16], kk[16]; u32x4v vreg;
  const float* LFp = p.LF + ((long)b * T_ + 16 * rq) * 2048 + h * 128 + k;
  const bf16_t* QSp = p.QS + ((long)b * T_ + 16 * rq) * 2048 + h * 128 + k;
  const bf16_t* KKp = p.KK + ((long)b * T_ + 16 * rq) * 2048 + h * 128 + k;
  const bf16_t* AVp = p.AVT + (((long)b * 16 + h) * 128 + 32 * vs + ((tid >> 3) & 31)) * T_ + (tid & 7) * 8;
#pragma unroll
  for (int i = 0; i < 16; ++i) { lf[i] = LFp[(long)i * 2048]; qs[i] = QSp[(long)i * 2048]; kk[i] = KKp[(long)i * 2048]; }
  vreg = *(const u32x4v*)(AVp);
  for (int c = 0; c < 32; ++c) {
    float cs[16];
    cs[0] = lf[0];
#pragma unroll
    for (int i = 1; i < 16; ++i) cs[i] = cs[i - 1] + lf[i];
    TOT[rq * 128 + k] = cs[15];
    __syncthreads();
    {
      const float t0 = TOT[k], t1 = TOT[128 + k], t2 = TOT[256 + k], t3 = TOT[384 + k];
      const float off = (rq > 0 ? t0 : 0.f) + (rq > 1 ? t1 : 0.f) + (rq > 2 ? t2 : 0.f);
      const float R = t0 + t1, GL = (t0 + t1) + (t2 + t3);
      if (rq == 0) { E1[k] = fexp_(GL); E2[k] = fexp_(GL - R); }
      unsigned kt[8];
#pragma unroll
      for (int i = 0; i < 16; i += 2) {
        const float G0 = off + cs[i], G1 = off + cs[i + 1];
        const float q0 = u_as_f((unsigned)qs[i] << 16) * fexp_(G0 - R), q1 = u_as_f((unsigned)qs[i + 1] << 16) * fexp_(G1 - R);
        const float k0 = u_as_f((unsigned)kk[i] << 16) * fexp_(R - G0), k1 = u_as_f((unsigned)kk[i + 1] << 16) * fexp_(R - G1);
        const unsigned qp = pg8::cvt_pk_bf16(q0, q1), kp = pg8::cvt_pk_bf16(k0, k1);
        *(LAS unsigned short*)(lds + HG_QT + (16 * rq + i) * 272 + k * 2) = (unsigned short)(qp & 0xFFFFu);
        *(LAS unsigned short*)(lds + HG_QT + (16 * rq + i + 1) * 272 + k * 2) = (unsigned short)(qp >> 16);
        *(LAS unsigned short*)(lds + HG_KT + (16 * rq + i) * 272 + k * 2) = (unsigned short)(kp & 0xFFFFu);
        *(LAS unsigned short*)(lds + HG_KT + (16 * rq + i + 1) * 272 + k * 2) = (unsigned short)(kp >> 16);
        kt[i >> 1] = kp;
      }
      *(LAS u32x4v*)(lds + HG_KTT + k * 144 + rq * 32) = (u32x4v){kt[0], kt[1], kt[2], kt[3]};
      *(LAS u32x4v*)(lds + HG_KTT + k * 144 + rq * 32 + 16) = (u32x4v){kt[4], kt[5], kt[6], kt[7]};
      if (tid < 256) *(LAS u32x4v*)(lds + HG_VTT + (tid >> 3) * 144 + (tid & 7) * 16) = vreg;
      if (wid < 4) {
#pragma unroll
        for (int r4 = 0; r4 < 4; ++r4) {
          const int kb = 32 * wid + 8 * r4 + 4 * hi;
          const f32x4 ra = *(const LAS f32x4*)(lds + HG_TOT + kb * 4), rb = *(const LAS f32x4*)(lds + HG_TOT + 512 + kb * 4);
          u32x2v w;
          w[0] = pg8::cvt_pk_bf16(S[4 * r4 + 0] * fexp_(ra[0] + rb[0]), S[4 * r4 + 1] * fexp_(ra[1] + rb[1]));
          w[1] = pg8::cvt_pk_bf16(S[4 * r4 + 2] * fexp_(ra[2] + rb[2]), S[4 * r4 + 3] * fexp_(ra[3] + rb[3]));
          *(LAS u32x2v*)(lds + HG_SPT + l31 * 272 + kb * 2) = w;
        }
      }
    }
    __syncthreads();
    if (c + 1 < 32) {
      const long adv = (long)(c + 1) * 64 * 2048;
#pragma unroll
      for (int i = 0; i < 16; ++i) { lf[i] = LFp[adv + (long)i * 2048]; qs[i] = QSp[adv + (long)i * 2048]; kk[i] = KKp[adv + (long)i * 2048]; }
      vreg = *(const u32x4v*)(AVp + (c + 1) * 64);
    }
    if (wid < 4) {
      f32x16 W;
#pragma unroll
      for (int r = 0; r < 16; ++r) W[r] = 0.f;
#pragma unroll
      for (int ss = 0; ss < 4; ++ss) {
        const bf16x8 a = *(const LAS bf16x8*)(lds + HG_KTT + (32 * wid + l31) * 144 + ss * 32 + hi * 16);
        const bf16x8 bb = *(const LAS bf16x8*)(lds + HG_VTT + l31 * 144 + ss * 32 + hi * 16);
        W = __builtin_amdgcn_mfma_f32_32x32x16_bf16(a, bb, W, 0, 0, 0);
      }
#pragma unroll
      for (int r4 = 0; r4 < 4; ++r4) {
        const int kb = 32 * wid + 8 * r4 + 4 * hi;
        const f32x4 e1 = *(const LAS f32x4*)(lds + HG_E1 + kb * 4), e2 = *(const LAS f32x4*)(lds + HG_E2 + kb * 4);
#pragma unroll
        for (int i = 0; i < 4; ++i) S[4 * r4 + i] = e1[i] * S[4 * r4 + i] + e2[i] * W[4 * r4 + i];
      }
    } else if (wid < 6) {
      const int th = wid - 4;
      f32x16 O;
#pragma unroll
      for (int r = 0; r < 16; ++r) O[r] = 0.f;
#pragma unroll
      for (int ks = 0; ks < 8; ++ks) {
        const bf16x8 a = *(const LAS bf16x8*)(lds + HG_QT + (32 * th + l31) * 272 + ks * 32 + hi * 16);
        const bf16x8 bb = *(const LAS bf16x8*)(lds + HG_SPT + l31 * 272 + ks * 32 + hi * 16);
        O = __builtin_amdgcn_mfma_f32_32x32x16_bf16(a, bb, O, 0, 0, 0);
      }
      for (int sh = 0; sh <= th; ++sh) {
        f32x16 X;
#pragma unroll
        for (int r = 0; r < 16; ++r) X[r] = 0.f;
#pragma unroll
        for (int ks = 0; ks < 8; ++ks) {
          const bf16x8 a = *(const LAS bf16x8*)(lds + HG_KT + (32 * sh + l31) * 272 + ks * 32 + hi * 16);
          const bf16x8 bb = *(const LAS bf16x8*)(lds + HG_QT + (32 * th + l31) * 272 + ks * 32 + hi * 16);
          X = __builtin_amdgcn_mfma_f32_32x32x16_bf16(a, bb, X, 0, 0, 0);
        }
        if (sh == th) {
#pragma unroll
          for (int r = 0; r < 16; ++r) if ((r & 3) + 8 * (r >> 2) + 4 * hi > l31) X[r] = 0.f;
        }
#pragma unroll
        for (int s2 = 0; s2 < 2; ++s2) {
          const bf16x8 ap = pack_bf16x8(X, 8 * s2);
          LAS unsigned char* vp = lds + HG_VTT + l31 * 144 + (32 * sh + 16 * s2 + 4 * hi) * 2;
          const u32x2v v0 = *(const LAS u32x2v*)(vp), v1 = *(const LAS u32x2v*)(vp + 16);
          const u32x4v vv = {v0[0], v0[1], v1[0], v1[1]};
          O = __builtin_amdgcn_mfma_f32_32x32x16_bf16(ap, __builtin_bit_cast(bf16x8, vv), O, 0, 0, 0);
        }
      }
      float* op = p.OA + ((long)b * T_ + c * 64 + 32 * th) * 2048 + h * 128 + 32 * vs + l31;
#pragma unroll
      for (int r = 0; r < 16; ++r) op[(long)((r & 3) + 8 * (r >> 2) + 4 * hi) * 2048] = O[r];
    }
  }
  __syncthreads();
}


constexpr int CP_K = 0, CP_V = 34816, CP_IMP = 69632, CP_SC = CP_IMP + 32768;

__device__ __forceinline__ void cmp_phase(const Params& p, LAS unsigned char* lds, const int tid, const int wid, const int first, const int step) {
  const int lane = tid & 63, l31 = lane & 31, hi = lane >> 5;
  const int hh = wid >> 1, th = wid & 1;
  const float NEG_INF_F = -__builtin_inff();
  for (int it = first; it < 512; it += step) {
    {
      const int qt = 31 - (it >> 4), bg = it & 15, b = bg >> 2, g = bg & 3;
      const int nkt = (qt >> 3) + 1;
      {
        const bf16_t* kc = p.KCb + (long)bg * 128 * 128;
        const bf16_t* vt = p.VCT + (long)bg * 128 * 128;
#pragma unroll
        for (int i = 0; i < 4; ++i) {
          const int c = tid + i * 512;
          const u32x4v kv_ = *(const u32x4v*)(kc + (c >> 4) * 128 + (c & 15) * 8);
          const u32x4v vv_ = *(const u32x4v*)(vt + (c >> 4) * 128 + (c & 15) * 8);
          *(LAS u32x4v*)(lds + CP_K + (c >> 4) * 272 + (c & 15) * 16) = kv_;
          *(LAS u32x4v*)(lds + CP_V + (c >> 4) * 272 + (c & 15) * 16) = vv_;
        }
      }
      const int head = g * 4 + hh;
      const int tq = qt * 64 + th * 32 + l31;
      const long qrow = (long)b * T_ + tq;
      const bf16_t* pbrow = p.PB + qrow * PB_W - PA_W;
      bf16x8 qf[8];
      {
        const bf16_t* qp = pbrow + C_BQ + head * 128 + 8 * hi;
#pragma unroll
        for (int ks = 0; ks < 8; ++ks) qf[ks] = scale_bf16x8(*(const bf16x8*)(qp + 16 * ks), 0.08838834764831845f * LOG2E_F);
      }
      const float slope2 = exp2f(-0.5f * (float)(head + 1)) * LOG2E_F;
      __syncthreads();
      int nv = tq >= 31 ? ((tq - 31) >> 4) : -1;
      if (nv > 126) nv = 126;
      f32x16 pr[4];
#pragma unroll
      for (int kt = 0; kt < 4; ++kt) {
        if (kt < nkt) {
          const float c0 = slope2 * (float)(16 * (32 * kt + 4 * hi) + 31 - tq);
#pragma unroll
          for (int r = 0; r < 16; ++r) pr[kt][r] = fmaf(slope2 * 16.0f, (float)((r & 3) + 8 * (r >> 2)), c0);
#pragma unroll
          for (int ks = 0; ks < 8; ++ks) {
            const bf16x8 a = *(const LAS bf16x8*)(lds + CP_K + (32 * kt + l31) * 272 + ks * 32 + hi * 16);
            pr[kt] = __builtin_amdgcn_mfma_f32_32x32x16_bf16(a, qf[ks], pr[kt], 0, 0, 0);
          }
#pragma unroll
          for (int r = 0; r < 16; ++r) if (32 * kt + (r & 3) + 8 * (r >> 2) + 4 * hi > nv) pr[kt][r] = NEG_INF_F;
        } else {
#pragma unroll
          for (int r = 0; r < 16; ++r) pr[kt][r] = NEG_INF_F;
        }
      }
      float mx = pr[0][0];
#pragma unroll
      for (int kt = 0; kt < 4; ++kt)
#pragma unroll
        for (int r = 0; r < 16; ++r) mx = fmaxf(mx, pr[kt][r]);
      mx = xhalf_max(mx);
      if (nv < 0) mx = 0.f;
      float ps = 0.f;
#pragma unroll
      for (int kt = 0; kt < 4; ++kt)
#pragma unroll
        for (int r = 0; r < 16; ++r) { pr[kt][r] = __builtin_amdgcn_exp2f(pr[kt][r] - mx); ps += pr[kt][r]; }
      ps = xhalf_sum(ps);
      const float inv = nv >= 0 ? 1.0f / ps : 0.f;
      {
        LAS float* imp = (LAS float*)(lds + CP_IMP) + ((th * 4 + hh) * 32 + l31) * 32;
        float eprev_same[4][4];
#pragma unroll
        for (int kt = 0; kt < 4; ++kt)
#pragma unroll
          for (int r4 = 0; r4 < 4; ++r4) eprev_same[kt][r4] = __shfl_xor(pr[kt][4 * r4 + 3], 32, 64);
#pragma unroll
        for (int kt = 0; kt < 4; ++kt)
#pragma unroll
          for (int r4 = 0; r4 < 4; ++r4) {
            const float gsum = (pr[kt][4 * r4] + pr[kt][4 * r4 + 1]) + (pr[kt][4 * r4 + 2] + pr[kt][4 * r4 + 3]);
            float e_hi0 = 0.f;
            if (r4 > 0) e_hi0 = eprev_same[kt][r4 - 1]; else if (kt > 0) e_hi0 = eprev_same[kt - 1][3];
            const float ep = hi ? eprev_same[kt][r4] : e_hi0;
            imp[8 * kt + 2 * r4 + hi] = (gsum + ep) * inv;
          }
      }
      f32x16 o[4];
#pragma unroll
      for (int db = 0; db < 4; ++db)
#pragma unroll
        for (int r = 0; r < 16; ++r) o[db][r] = 0.f;
#pragma unroll
      for (int kt = 0; kt < 4; ++kt) {
        if (kt < nkt) {
#pragma unroll
          for (int s = 0; s < 2; ++s) {
            const bf16x8 pf = pack_bf16x8(pr[kt], 8 * s);
#pragma unroll
            for (int db = 0; db < 4; ++db) {
              LAS unsigned char* vp = lds + CP_V + (32 * db + l31) * 272 + (32 * kt + 16 * s + 4 * hi) * 2;
              const u32x2v v0 = *(const LAS u32x2v*)(vp);
              const u32x2v v1 = *(const LAS u32x2v*)(vp + 16);
              const u32x4v vv = {v0[0], v0[1], v1[0], v1[1]};
              o[db] = __builtin_amdgcn_mfma_f32_32x32x16_bf16(__builtin_bit_cast(bf16x8, vv), pf, o[db], 0, 0, 0);
            }
          }
        }
      }
      {
        const float coef = fsigmoid_(bf2f(pbrow[C_GT + head * 3 + 0])) * inv;
        float* yb = p.YB + qrow * 2048 + head * 128;
        f32x4 yv[4][4];
#pragma unroll
        for (int db = 0; db < 4; ++db)
#pragma unroll
          for (int r4 = 0; r4 < 4; ++r4) yv[db][r4] = *(const f32x4*)(yb + 32 * db + 8 * r4 + 4 * hi);
#pragma unroll
        for (int db = 0; db < 4; ++db)
#pragma unroll
          for (int r4 = 0; r4 < 4; ++r4) {
            f32x4 y = yv[db][r4];
#pragma unroll
            for (int i = 0; i < 4; ++i) y[i] += coef * o[db][4 * r4 + i];
            *(f32x4*)(yb + 32 * db + 8 * r4 + 4 * hi) = y;
          }
      }
      __syncthreads();
      {
        LAS float* impf = (LAS float*)(lds + CP_IMP);
        LAS float* sc = (LAS float*)(lds + CP_SC);
#pragma unroll
        for (int pass = 0; pass < 4; ++pass) {
          const int t = pass * 16 + (tid >> 5), j = tid & 31;
          const int th_ = t >> 5, tl = t & 31;
          float v = 0.f;
#pragma unroll
          for (int h4 = 0; h4 < 4; ++h4) v += impf[((th_ * 4 + h4) * 32 + tl) * 32 + j];
          float scv;
          if (j == 0 || j == qt || j == qt - 1) scv = 1e30f; else if (j <= qt) scv = v; else scv = -1e30f;
          sc[t * 33 + j] = scv;
        }
        __syncthreads();
#pragma unroll
        for (int pass = 0; pass < 4; ++pass) {
          const int t = pass * 16 + (tid >> 5), j = tid & 31;
          const float sj = sc[t * 33 + j];
          int cnt = 0;
#pragma unroll
          for (int i = 0; i < 32; ++i) { const float si = sc[t * 33 + i]; cnt += (si > sj || (si == sj && i < j)) ? 1 : 0; }
          const unsigned long long bal = __ballot(cnt < 16);
          if ((lane & 31) == 0) p.SELM[((long)b * T_ + qt * 64 + t) * 4 + g] = (int)(unsigned)(hi ? (bal >> 32) : bal);
        }
      }
      __syncthreads();
    }
  }
}


constexpr int HF_TOT = 0, HF_E1 = 4096, HF_E2 = 4608, HF_QT = 5120, HF_KT = HF_QT + 17408, HF_KTT = HF_KT + 17408,
              HF_VTT = HF_KTT + 18432, HF_SPT = HF_VTT + 18432, HF_SS = HF_SPT + 34816, HF_QHT = HF_SS + 2048,
              HF_GN = 131072;

__device__ __forceinline__ void hgrn_emit(const Params& p, const int e, LAS unsigned char* lds, const f32x16& O, const u32x2v (&gz)[4],
                                          const long row, const int h, const int th, const int vq, const int l31, const int hi, const int par) {
  const int t = 32 * th + l31 + par * 256;
  const float ss = (*(const LAS float*)(lds + HF_SS + (0 * 64 + t) * 4) + *(const LAS float*)(lds + HF_SS + (1 * 64 + t) * 4)) +
                   (*(const LAS float*)(lds + HF_SS + (2 * 64 + t) * 4) + *(const LAS float*)(lds + HF_SS + (3 * 64 + t) * 4));
  const float rstd = __builtin_amdgcn_rsqf(ss * (1.0f / 128) + NORM_EPS);
#pragma unroll
  for (int r4 = 0; r4 < 4; ++r4) {
    const int c = h * 128 + 32 * vq + 8 * r4 + 4 * hi;
    const f32x4 gn = *(const LAS f32x4*)(lds + HF_GN + (32 * vq + 8 * r4 + 4 * hi) * 4);
    const float z0 = u_as_f(gz[r4][0] << 16), z1 = u_as_f(gz[r4][0] & 0xFFFF0000u), z2 = u_as_f(gz[r4][1] << 16), z3 = u_as_f(gz[r4][1] & 0xFFFF0000u);
    u32x2v w;
    w[0] = pg8::cvt_pk_bf16(O[4 * r4 + 0] * rstd * gn[0] * fsilu_(z0), O[4 * r4 + 1] * rstd * gn[1] * fsilu_(z1));
    w[1] = pg8::cvt_pk_bf16(O[4 * r4 + 2] * rstd * gn[2] * fsilu_(z2), O[4 * r4 + 3] * rstd * gn[3] * fsilu_(z3));
    *(u32x2v*)(p.Ymix + row * 4096 + c) = w;
  }
}

__device__ __forceinline__ void hgrn_full_phase(const Params& p, const int e, LAS unsigned char* lds, const int tid, const int wid) {
  const int lane = tid & 63, l31 = lane & 31, hi = lane >> 5;
  const int item = blockIdx.x;
  const int h = item & 15, b = item >> 4;
  const int k0 = 2 * lane, rg = wid;
  const int vq = wid & 3, wg = wid >> 2;
  LAS float* TOT = (LAS float*)(lds + HF_TOT);
  LAS float* E1 = (LAS float*)(lds + HF_E1);
  LAS float* E2 = (LAS float*)(lds + HF_E2);
  if (tid < 128) *(LAS float*)(lds + HF_GN + tid * 4) = p.hgrn_norm_w[e * 2048 + h * 128 + tid];
  f32x16 S0, S1, O, Op;
#pragma unroll
  for (int r = 0; r < 16; ++r) { S0[r] = 0.f; S1[r] = 0.f; O[r] = 0.f; Op[r] = 0.f; }
  pg8::f32x2_t lf[8]; unsigned qs[8], kk[8]; u32x4v vreg[2]; u32x2v gz[4];
  const float* LFp = p.LF + ((long)b * T_ + 8 * rg) * 2048 + h * 128 + k0;
  const bf16_t* QSp = p.QS + ((long)b * T_ + 8 * rg) * 2048 + h * 128 + k0;
  const bf16_t* KKp = p.KK + ((long)b * T_ + 8 * rg) * 2048 + h * 128 + k0;
  const bf16_t* AVp0 = p.AVT + (((long)b * 16 + h) * 128 + (tid >> 3)) * T_ + (tid & 7) * 8;
  const bf16_t* AVp1 = AVp0 + (long)64 * T_;
  const bf16_t* GZp = p.PB + ((long)b * T_ + 32 * wg + l31) * PB_W + (C_AG - PA_W) + h * 128 + 32 * vq + 4 * hi;
#pragma unroll
  for (int i = 0; i < 8; ++i) { lf[i] = *(const pg8::f32x2_t*)(LFp + (long)i * 2048); qs[i] = *(const unsigned*)(QSp + (long)i * 2048); kk[i] = *(const unsigned*)(KKp + (long)i * 2048); }
  vreg[0] = *(const u32x4v*)(AVp0); vreg[1] = *(const u32x4v*)(AVp1);
  for (int c = 0; c < 32; ++c) {
    pg8::f32x2_t cs[8];
    cs[0] = lf[0];
#pragma unroll
    for (int i = 1; i < 8; ++i) { cs[i].x = cs[i - 1].x + lf[i].x; cs[i].y = cs[i - 1].y + lf[i].y; }
    *(LAS pg8::f32x2_t*)(lds + HF_TOT + (rg * 128 + k0) * 4) = cs[7];
    __syncthreads();
    const int cn = c + 1 < 32 ? c + 1 : 31;
    {
#pragma unroll
      for (int i = 0; i < 8; ++i) lf[i] = *(const pg8::f32x2_t*)(LFp + (long)cn * 64 * 2048 + (long)i * 2048);
    }
    {
      pg8::f32x2_t off = {0.f, 0.f}, R = {0.f, 0.f}, GL = {0.f, 0.f};
#pragma unroll
      for (int g8 = 0; g8 < 8; ++g8) {
        const pg8::f32x2_t tv = *(const LAS pg8::f32x2_t*)(lds + HF_TOT + (g8 * 128 + k0) * 4);
        if (g8 < rg) { off.x += tv.x; off.y += tv.y; }
        if (g8 < 4) { R.x += tv.x; R.y += tv.y; }
        GL.x += tv.x; GL.y += tv.y;
      }
      if (rg == 0) {
        *(LAS pg8::f32x2_t*)(lds + HF_E1 + k0 * 4) = (pg8::f32x2_t){fexp_(GL.x), fexp_(GL.y)};
        *(LAS pg8::f32x2_t*)(lds + HF_E2 + k0 * 4) = (pg8::f32x2_t){fexp_(GL.x - R.x), fexp_(GL.y - R.y)};
      }
      const pg8::f32x2_t eR = {fexp_(R.x), fexp_(R.y)};
      unsigned kta[4], ktb[4];
      unsigned short klo[8], khi[8];
#pragma unroll
      for (int i = 0; i < 8; ++i) {
        const float Gx = off.x + cs[i].x, Gy = off.y + cs[i].y;
        const float qx = u_as_f(qs[i] << 16) * fexp_(Gx - R.x), qy = u_as_f(qs[i] & 0xFFFF0000u) * fexp_(Gy - R.y);
        const float kx = u_as_f(kk[i] << 16) * fexp_(R.x - Gx), ky = u_as_f(kk[i] & 0xFFFF0000u) * fexp_(R.y - Gy);
        const unsigned qp = pg8::cvt_pk_bf16(qx, qy), kp = pg8::cvt_pk_bf16(kx, ky);
        *(LAS unsigned*)(lds + HF_QT + (8 * rg + i) * 272 + k0 * 2) = qp;
        *(LAS unsigned*)(lds + HF_QHT + (8 * rg + i) * 272 + k0 * 2) = pg8::cvt_pk_bf16(qx * eR.x, qy * eR.y);
        *(LAS unsigned*)(lds + HF_KT + (8 * rg + i) * 272 + k0 * 2) = kp;
        klo[i] = (unsigned short)(kp & 0xFFFFu); khi[i] = (unsigned short)(kp >> 16);
      }
#pragma unroll
      for (int i = 0; i < 4; ++i) { kta[i] = (unsigned)klo[2 * i] | ((unsigned)klo[2 * i + 1] << 16); ktb[i] = (unsigned)khi[2 * i] | ((unsigned)khi[2 * i + 1] << 16); }
      *(LAS u32x4v*)(lds + HF_KTT + k0 * 144 + rg * 16) = (u32x4v){kta[0], kta[1], kta[2], kta[3]};
      *(LAS u32x4v*)(lds + HF_KTT + (k0 + 1) * 144 + rg * 16) = (u32x4v){ktb[0], ktb[1], ktb[2], ktb[3]};
      *(LAS u32x4v*)(lds + HF_VTT + (tid >> 3) * 144 + (tid & 7) * 16) = vreg[0];
      *(LAS u32x4v*)(lds + HF_VTT + (64 + (tid >> 3)) * 144 + (tid & 7) * 16) = vreg[1];
#pragma unroll
      for (int tt = 0; tt < 2; ++tt) {
        const int kq = 2 * wg + tt;
#pragma unroll
        for (int r4 = 0; r4 < 4; ++r4) {
          const int kb = 32 * kq + 8 * r4 + 4 * hi;
          u32x2v w;
          if (tt == 0) {
            w[0] = pg8::cvt_pk_bf16(S0[4 * r4 + 0], S0[4 * r4 + 1]); w[1] = pg8::cvt_pk_bf16(S0[4 * r4 + 2], S0[4 * r4 + 3]);
          } else {
            w[0] = pg8::cvt_pk_bf16(S1[4 * r4 + 0], S1[4 * r4 + 1]); w[1] = pg8::cvt_pk_bf16(S1[4 * r4 + 2], S1[4 * r4 + 3]);
          }
          *(LAS u32x2v*)(lds + HF_SPT + (32 * vq + l31) * 272 + kb * 2) = w;
        }
      }
    }
    __syncthreads();
    if (c > 0) hgrn_emit(p, e, lds, Op, gz, (long)b * T_ + (c - 1) * 64 + 32 * wg + l31, h, wg, vq, l31, hi, (c - 1) & 1);
    {
      const long adv = (long)cn * 64 * 2048;
#pragma unroll
      for (int i = 0; i < 8; ++i) { qs[i] = *(const unsigned*)(QSp + adv + (long)i * 2048); kk[i] = *(const unsigned*)(KKp + adv + (long)i * 2048); }
      vreg[0] = *(const u32x4v*)(AVp0 + cn * 64); vreg[1] = *(const u32x4v*)(AVp1 + cn * 64);
    }
#pragma unroll
    for (int r4 = 0; r4 < 4; ++r4) gz[r4] = *(const u32x2v*)(GZp + (long)c * 64 * PB_W + 8 * r4);
    {
#pragma unroll
      for (int r = 0; r < 16; ++r) O[r] = 0.f;
#pragma unroll
      for (int ks = 0; ks < 8; ++ks) {
        const bf16x8 a = *(const LAS bf16x8*)(lds + HF_SPT + (32 * vq + l31) * 272 + ks * 32 + hi * 16);
        const bf16x8 bb = *(const LAS bf16x8*)(lds + HF_QHT + (32 * wg + l31) * 272 + ks * 32 + hi * 16);
        O = __builtin_amdgcn_mfma_f32_32x32x16_bf16(a, bb, O, 0, 0, 0);
      }
      for (int sh = 0; sh <= wg; ++sh) {
        f32x16 X;
#pragma unroll
        for (int r = 0; r < 16; ++r) X[r] = 0.f;
#pragma unroll
        for (int ks = 0; ks < 8; ++ks) {
          const bf16x8 a = *(const LAS bf16x8*)(lds + HF_KT + (32 * sh + l31) * 272 + ks * 32 + hi * 16);
          const bf16x8 bb = *(const LAS bf16x8*)(lds + HF_QT + (32 * wg + l31) * 272 + ks * 32 + hi * 16);
          X = __builtin_amdgcn_mfma_f32_32x32x16_bf16(a, bb, X, 0, 0, 0);
        }
        if (sh == wg) {
#pragma unroll
          for (int r = 0; r < 16; ++r) if ((r & 3) + 8 * (r >> 2) + 4 * hi > l31) X[r] = 0.f;
        }
#pragma unroll
        for (int s2 = 0; s2 < 2; ++s2) {
          const bf16x8 xp = pack_bf16x8(X, 8 * s2);
          LAS unsigned char* vp = lds + HF_VTT + (32 * vq + l31) * 144 + (32 * sh + 16 * s2 + 4 * hi) * 2;
          const u32x2v v0 = *(const LAS u32x2v*)(vp), v1 = *(const LAS u32x2v*)(vp + 16);
          const u32x4v vv = {v0[0], v0[1], v1[0], v1[1]};
          O = __builtin_amdgcn_mfma_f32_32x32x16_bf16(__builtin_bit_cast(bf16x8, vv), xp, O, 0, 0, 0);
        }
      }
      {
        float sq = 0.f;
#pragma unroll
        for (int r = 0; r < 16; ++r) sq += O[r] * O[r];
        sq = xhalf_sum(sq);
        if (hi == 0) *(LAS float*)(lds + HF_SS + ((c & 1) * 256 + vq * 64 + 32 * wg + l31) * 4) = sq;
        Op = O;
      }
#pragma unroll
      for (int tt = 0; tt < 2; ++tt) {
        const int kq = 2 * wg + tt;
        f32x16 W;
#pragma unroll
        for (int r = 0; r < 16; ++r) W[r] = 0.f;
#pragma unroll
        for (int ss = 0; ss < 4; ++ss) {
          const bf16x8 a = *(const LAS bf16x8*)(lds + HF_KTT + (32 * kq + l31) * 144 + ss * 32 + hi * 16);
          const bf16x8 bb = *(const LAS bf16x8*)(lds + HF_VTT + (32 * vq + l31) * 144 + ss * 32 + hi * 16);
          W = __builtin_amdgcn_mfma_f32_32x32x16_bf16(a, bb, W, 0, 0, 0);
        }
#pragma unroll
        for (int r4 = 0; r4 < 4; ++r4) {
          const int kb = 32 * kq + 8 * r4 + 4 * hi;
          const f32x4 e1 = *(const LAS f32x4*)(lds + HF_E1 + kb * 4), e2 = *(const LAS f32x4*)(lds + HF_E2 + kb * 4);
#pragma unroll
          for (int i = 0; i < 4; ++i) {
            if (tt == 0) S0[4 * r4 + i] = e1[i] * S0[4 * r4 + i] + e2[i] * W[4 * r4 + i];
            else S1[4 * r4 + i] = e1[i] * S1[4 * r4 + i] + e2[i] * W[4 * r4 + i];
          }
        }
      }
    }
  }
  __syncthreads();
  hgrn_emit(p, e, lds, Op, gz, (long)b * T_ + 31 * 64 + 32 * wg + l31, h, wg, vq, l31, hi, 1);
  __syncthreads();
}

template <int MODE>
__device__ __forceinline__ void attn_phase(const Params& p, LAS unsigned char* lds, const int tid) {
  const int wid = __builtin_amdgcn_readfirstlane(tid >> 6), lane = tid & 63, l31 = lane & 31, hi = lane >> 5;
  const int hh = wid >> 1, th = wid & 1;
  LAS unsigned* umask_p = (LAS unsigned*)(lds + 2 * AT_BUF);
  const float NEG_INF_F = -__builtin_inff();
  const int u0 = MODE == 0 ? (int)blockIdx.x - 80 : (int)blockIdx.x, ustep = MODE == 0 ? 176 : NBLK, uend = MODE == 0 ? 512 : 256;
  for (int u = u0; u < uend; u += ustep) {
    for (int half = 0; half < (MODE == 0 ? 1 : 2); ++half) {
      const int it = MODE == 0 ? u : (half ? 511 - u : u);
      const int qt = 31 - (it >> 4), bg = it & 15, b = bg >> 2, g = bg & 3;
      const int head = g * 4 + hh;
      const int tq = qt * 64 + th * 32 + l31;
      const long qrow = (long)b * T_ + tq;
      const bf16_t* pbrow = p.PB + qrow * PB_W - PA_W;
      bf16x8 qf[8];
      {
        const bf16_t* qp = pbrow + C_BQ + head * 128 + 8 * hi;
#pragma unroll
        for (int ks = 0; ks < 8; ++ks) qf[ks] = scale_bf16x8(*(const bf16x8*)(qp + 16 * ks), 0.08838834764831845f * LOG2E_F);
      }
      const float slope2 = exp2f(-0.5f * (float)(head + 1)) * LOG2E_F;
      const unsigned selm = MODE == 0 ? 0u : (unsigned)p.SELM[qrow * 4 + g];
      unsigned wor = selm;
#pragma unroll
      for (int off = 1; off < 32; off <<= 1) wor |= (unsigned)__shfl_xor((int)wor, off, 64);
      unsigned um = 0u;
      if (MODE != 0) {
        if (tid == 0) *umask_p = 0u;
        __syncthreads();
        if (lane == 0) atomicOr((unsigned*)umask_p, wor);
        __syncthreads();
        um = *umask_p;
      }
      for (int br = (MODE == 0 ? 1 : 0); br < (MODE == 0 ? 2 : 1); ++br) {
        unsigned todo;
        const bf16_t* Kb; const bf16_t* VTb; int W;
        if (br == 0) {
          todo = um & (qt == 31 ? 0xFFFFFFFFu : ((2u << qt) - 1u));
          Kb = p.PB + (long)b * T_ * PB_W + (C_KS - PA_W) + g * 128;
          VTb = p.VT + ((long)(0 * NB + b) * 4 + g) * 128 * T_;
          W = 1 << 20;
        } else {
          const int lo = qt - 8 < 0 ? 0 : qt - 8;
          todo = (qt == 31 ? 0xFFFFFFFFu : ((2u << qt) - 1u)) & ~((1u << lo) - 1u);
          Kb = p.PB + (long)b * T_ * PB_W + (C_KW - PA_W) + g * 128;
          VTb = p.VT + ((long)(1 * NB + b) * 4 + g) * 128 * T_;
          W = 512;
        }
        float m = -1e30f, l = 0.f;
        f32x16 o[4];
#pragma unroll
        for (int db = 0; db < 4; ++db)
#pragma unroll
          for (int r = 0; r < 16; ++r) o[db][r] = 0.f;
        u32x4v kreg[2], vreg[2];
        int j = __builtin_ctz(todo);
        todo &= todo - 1u;
#pragma unroll
        for (int i = 0; i < 2; ++i) {
          const int c = tid + i * 512;
          kreg[i] = *(const u32x4v*)(Kb + (long)(j * 64 + (c >> 4)) * PB_W + (c & 15) * 8);
          vreg[i] = *(const u32x4v*)(VTb + (long)(c >> 3) * T_ + j * 64 + (c & 7) * 8);
        }
#pragma unroll
        for (int i = 0; i < 2; ++i) {
          const int c = tid + i * 512;
          *(LAS u32x4v*)(lds + (c >> 4) * AT_KSTR + (c & 15) * 16) = kreg[i];
          LAS unsigned char* vp = lds + AT_KBYTES + (c >> 3) * AT_VSTR + (c & 7) * 16;
          *(LAS u32x2v*)(vp) = (u32x2v){vreg[i][0], vreg[i][1]};
          *(LAS u32x2v*)(vp + 8) = (u32x2v){vreg[i][2], vreg[i][3]};
        }
        __syncthreads();
        int cur = 0;
        for (;;) {
          const int jn = todo ? __builtin_ctz(todo) : -1;
          todo &= todo - 1u;
          if (jn >= 0) {
#pragma unroll
            for (int i = 0; i < 2; ++i) {
              const int c = tid + i * 512;
              kreg[i] = *(const u32x4v*)(Kb + (long)(jn * 64 + (c >> 4)) * PB_W + (c & 15) * 8);
              vreg[i] = *(const u32x4v*)(VTb + (long)(c >> 3) * T_ + jn * 64 + (c & 7) * 8);
            }
          }
          {
            LAS unsigned char* kb_ = lds + cur * AT_BUF;
            LAS unsigned char* vb_ = kb_ + AT_KBYTES;
            const int kb = j * 64 - tq;
            const float c0 = slope2 * (float)(kb + 4 * hi);
            f32x16 p0, p1;
#pragma unroll
            for (int r = 0; r < 16; ++r) {
              const float kc = (float)((r & 3) + 8 * (r >> 2));
              p0[r] = fmaf(slope2, kc, c0);
              p1[r] = fmaf(slope2, kc + 32.f, c0);
            }
#pragma unroll
            for (int ks = 0; ks < 8; ++ks) {
              const bf16x8 a0 = *(const LAS bf16x8*)(kb_ + l31 * AT_KSTR + ks * 32 + hi * 16);
              const bf16x8 a1 = *(const LAS bf16x8*)(kb_ + (32 + l31) * AT_KSTR + ks * 32 + hi * 16);
              p0 = __builtin_amdgcn_mfma_f32_32x32x16_bf16(a0, qf[ks], p0, 0, 0, 0);
              p1 = __builtin_amdgcn_mfma_f32_32x32x16_bf16(a1, qf[ks], p1, 0, 0, 0);
            }
            __builtin_amdgcn_sched_group_barrier(0x100, 6, 0);
#pragma unroll
            for (int q_ = 0; q_ < 10; ++q_) { __builtin_amdgcn_sched_group_barrier(0x008, 1, 0); __builtin_amdgcn_sched_group_barrier(0x100, 1, 0); }
            __builtin_amdgcn_sched_group_barrier(0x008, 6, 0);
            const bool boundary = (j == qt) || (br == 1 && j == qt - 8);
            if (boundary) {
              const int dq = -kb - 4 * hi;
#pragma unroll
              for (int r = 0; r < 16; ++r) {
                const int c = (r & 3) + 8 * (r >> 2);
                if ((unsigned)(dq - c) >= (unsigned)W) p0[r] = NEG_INF_F;
                if ((unsigned)(dq - c - 32) >= (unsigned)W) p1[r] = NEG_INF_F;
              }
            }
            if (br == 0 && !((selm >> j) & 1u)) {
#pragma unroll
              for (int r = 0; r < 16; ++r) { p0[r] = NEG_INF_F; p1[r] = NEG_INF_F; }
            }
            float mx = p0[0];
#pragma unroll
            for (int r = 1; r < 16; ++r) mx = fmaxf(mx, p0[r]);
#pragma unroll
            for (int r = 0; r < 16; ++r) mx = fmaxf(mx, p1[r]);
            mx = xhalf_max(mx);
            const float mn = fmaxf(m, mx);
            const float alpha = __builtin_amdgcn_exp2f(m - mn);
            m = mn;
            float ps = 0.f;
#pragma unroll
            for (int r = 0; r < 16; ++r) { p0[r] = __builtin_amdgcn_exp2f(p0[r] - mn); ps += p0[r]; }
#pragma unroll
            for (int r = 0; r < 16; ++r) { p1[r] = __builtin_amdgcn_exp2f(p1[r] - mn); ps += p1[r]; }
            l = l * alpha + ps;
#pragma unroll
            for (int db = 0; db < 4; ++db)
#pragma unroll
              for (int r = 0; r < 16; ++r) o[db][r] *= alpha;
            bf16x8 pf[4];
            pf[0] = pack_bf16x8(p0, 0); pf[1] = pack_bf16x8(p0, 8); pf[2] = pack_bf16x8(p1, 0); pf[3] = pack_bf16x8(p1, 8);
#pragma unroll
            for (int db = 0; db < 4; ++db) {
#pragma unroll
              for (int s4 = 0; s4 < 4; ++s4) {
                LAS unsigned char* vp = vb_ + (32 * db + l31) * AT_VSTR + (16 * s4 + 4 * hi) * 2;
                const u32x2v v0 = *(const LAS u32x2v*)(vp);
                const u32x2v v1 = *(const LAS u32x2v*)(vp + 16);
                const u32x4v vv = {v0[0], v0[1], v1[0], v1[1]};
                o[db] = __builtin_amdgcn_mfma_f32_32x32x16_bf16(__builtin_bit_cast(bf16x8, vv), pf[s4], o[db], 0, 0, 0);
              }
            }
            __builtin_amdgcn_sched_group_barrier(0x100, 6, 1);
#pragma unroll
            for (int q_ = 0; q_ < 10; ++q_) { __builtin_amdgcn_sched_group_barrier(0x008, 1, 1); __builtin_amdgcn_sched_group_barrier(0x100, 1, 1); }
            __builtin_amdgcn_sched_group_barrier(0x008, 6, 1);
          }
          if (jn < 0) break;
          {
            LAS unsigned char* nb_ = lds + (cur ^ 1) * AT_BUF;
#pragma unroll
            for (int i = 0; i < 2; ++i) {
              const int c = tid + i * 512;
              *(LAS u32x4v*)(nb_ + (c >> 4) * AT_KSTR + (c & 15) * 16) = kreg[i];
              LAS unsigned char* vp = nb_ + AT_KBYTES + (c >> 3) * AT_VSTR + (c & 7) * 16;
              *(LAS u32x2v*)(vp) = (u32x2v){vreg[i][0], vreg[i][1]};
              *(LAS u32x2v*)(vp + 8) = (u32x2v){vreg[i][2], vreg[i][3]};
            }
          }
          __syncthreads();
          cur ^= 1;
          j = jn;
        }
        __syncthreads();
        {
          const float lt = xhalf_sum(l);
          const float gate = sigmoidf_(bf2f(pbrow[C_GT + head * 3 + 1 + br]));
          const float coef = gate / lt;
          LAS unsigned char* orow = lds + (wid * 32 + l31) * AT_OSTR + 16 * hi;
#pragma unroll
          for (int db = 0; db < 4; ++db) {
#pragma unroll
            for (int r4 = 0; r4 < 4; ++r4) {
              f32x4 y;
#pragma unroll
              for (int i = 0; i < 4; ++i) y[i] = coef * o[db][4 * r4 + i];
              *(LAS f32x4*)(orow + (32 * db + 8 * r4) * 4) = y;
            }
          }
        }
        __syncthreads();
        {
          const int hsel = lane >> 5, dd = (lane & 31) * 4;
          const long trow0 = (long)b * T_ + qt * 64 + wid * 8;
#pragma unroll
          for (int hp = 0; hp < 2; ++hp) {
            const int hh2 = hp * 2 + hsel;
            f32x4 yv[8]; u32x2v gv[8];
            if (MODE != 0) {
#pragma unroll
              for (int k = 0; k < 8; ++k) {
                const long tr = trow0 + k;
                yv[k] = *(const f32x4*)(p.YB + tr * 2048 + (g * 4 + hh2) * 128 + dd);
                gv[k] = *(const u32x2v*)(p.PB + tr * PB_W - PA_W + C_BG + (g * 4 + hh2) * 128 + dd);
              }
            }
#pragma unroll
            for (int k = 0; k < 8; ++k) {
              const int t = wid * 8 + k;
              const f32x4 v = *(const LAS f32x4*)(lds + ((hh2 * 2 + (t >> 5)) * 32 + (t & 31)) * AT_OSTR + dd * 4);
              const long tr = trow0 + k;
              if (MODE == 0) {
                *(f32x4*)(p.YB + tr * 2048 + (g * 4 + hh2) * 128 + dd) = v;
              } else {
                f32x4 y = yv[k];
#pragma unroll
                for (int i = 0; i < 4; ++i) y[i] += v[i];
                const u32x2v gz = gv[k];
                const float z0 = u_as_f(gz[0] << 16), z1 = u_as_f(gz[0] & 0xFFFF0000u), z2 = u_as_f(gz[1] << 16), z3 = u_as_f(gz[1] & 0xFFFF0000u);
                u32x2v w;
                w[0] = pg8::cvt_pk_bf16(y[0] * fsilu_(z0), y[1] * fsilu_(z1));
                w[1] = pg8::cvt_pk_bf16(y[2] * fsilu_(z2), y[3] * fsilu_(z3));
                *(u32x2v*)(p.Ymix + tr * 4096 + 2048 + (g * 4 + hh2) * 128 + dd) = w;
              }
            }
          }
        }
        __syncthreads();
      }
    }
  }
}


constexpr int LDS_BYTES = 147456;


__device__ __forceinline__ float wave_sum(float v) {
#pragma unroll
  for (int off = 32; off >= 1; off >>= 1) v += __shfl_xor(v, off, 64);
  return v;
}
template <bool FINAL, bool COPY>
__device__ __forceinline__ void rmsnorm_phase(const float* __restrict__ src, float* __restrict__ X, const float* __restrict__ w,
                                              bf16_t* __restrict__ Hb, float* __restrict__ out, const int tid, const int wid) {
  const int lane = tid & 63;
  for (int row = blockIdx.x * 8 + wid; row < M_; row += NBLK * 8) {
    const float* xr = src + (size_t)row * D_;
    f32x4 v[8];
    float ss = 0.f;
#pragma unroll
    for (int i = 0; i < 8; ++i) {
      v[i] = *(const f32x4*)(xr + lane * 4 + 256 * i);
      ss += v[i][0] * v[i][0] + v[i][1] * v[i][1] + v[i][2] * v[i][2] + v[i][3] * v[i][3];
    }
    ss = wave_sum(ss);
    const float rstd = 1.0f / sqrtf(ss * (1.0f / D_) + NORM_EPS);
#pragma unroll
    for (int i = 0; i < 8; ++i) {
      const int c = lane * 4 + 256 * i;
      const f32x4 ww = *(const f32x4*)(w + c);
      if (COPY) *(f32x4*)(X + (size_t)row * D_ + c) = v[i];
      if (FINAL) {
        f32x4 o;
#pragma unroll
        for (int j = 0; j < 4; ++j) o[j] = v[i][j] * rstd * ww[j];
        *(f32x4*)(out + (size_t)row * D_ + c) = o;
      } else {
        uint2 pk;
        pk.x = pg8::cvt_pk_bf16(v[i][0] * rstd * ww[0], v[i][1] * rstd * ww[1]);
        pk.y = pg8::cvt_pk_bf16(v[i][2] * rstd * ww[2], v[i][3] * rstd * ww[3]);
        *(uint2*)(Hb + (size_t)row * D_ + c) = pk;
      }
    }
  }
}
__device__ __forceinline__ void hgrn_post_phase(const Params& p, const int e, const int tid, const int wid) {
  const int lane = tid & 63;
  for (int u = blockIdx.x * 8 + wid; u < M_ * 16; u += NBLK * 8) {
    const long row = u >> 4; const int h = u & 15;
    const int c = h * 128 + 2 * lane;
    const float2 o = *(const float2*)(p.OA + row * 2048 + c);
    const float ss = wave_sum(o.x * o.x + o.y * o.y);
    const float rstd = 1.0f / sqrtf(ss * (1.0f / 128) + NORM_EPS);
    const float2 gn = *(const float2*)(p.hgrn_norm_w + e * 2048 + c);
    const unsigned gz = *(const unsigned*)(p.PB + row * PB_W + (C_AG - PA_W) + c);
    const float z0 = u_as_f(gz << 16), z1 = u_as_f(gz & 0xFFFF0000u);
    *(unsigned*)(p.Ymix + row * 4096 + c) = pg8::cvt_pk_bf16(o.x * rstd * gn.x * fsilu_(z0), o.y * rstd * gn.y * fsilu_(z1));
  }
}
__device__ __forceinline__ void c1_phase(const Params& p, const int tid, const int wid) {
  const int lane = tid & 63;
  for (int u = blockIdx.x * 8 + wid; u < 512; u += NBLK * 8) {
    const int e = u & 127, kv = (u >> 7) & 1, l = u >> 8;
    const float* pe = (kv ? p.cmp_pe_v : p.cmp_pe_k) + (long)l * 4096;
    const float* w1 = (kv ? p.cmp_w1_v : p.cmp_w1_k) + (long)l * 4096 * 128;
    float acc = 0.f;
    for (int i = lane; i < 4096; i += 64) acc += pe[i] * w1[(long)i * 128 + e];
    acc = wave_sum(acc);
    if (lane == 0) p.C1[u] = acc;
  }
}


__device__ __forceinline__ void conv_phase(const Params& p, const int o, const int tid) {
  const float* cw = p.rg_conv_w + (long)o * 4 * DR;
  const float* cb = p.rg_conv_b + (long)o * DR;
  for (int i = blockIdx.x * NTHREADS + tid; i < (M_ / 16) * 640; i += NBLK * NTHREADS) {
    const int rgp = i / 640, c = (i - rgp * 640) * 4, row0 = rgp * 16, t0 = row0 & (T_ - 1);
    const f32x4 bias = *(const f32x4*)(cb + c);
    const f32x4 w0 = *(const f32x4*)(cw + c), w1 = *(const f32x4*)(cw + DR + c), w2 = *(const f32x4*)(cw + 2 * DR + c), w3 = *(const f32x4*)(cw + 3 * DR + c);
    uint2 xr[19];
#pragma unroll
    for (int j = 0; j < 19; ++j) {
      xr[j] = make_uint2(0u, 0u);
      if (j >= 3 || t0 > 0) xr[j] = *(const uint2*)(p.XB + (long)(row0 + j - 3) * DR + c);
    }
    bf16_t* dst = p.XCb + ((long)(c >> 8) * M_ + row0) * 256 + (c & 255);
#pragma unroll
    for (int r = 0; r < 16; ++r) {
      f32x4 acc = bias;
      const f32x4 ws[4] = {w0, w1, w2, w3};
#pragma unroll
      for (int j = 0; j < 4; ++j) {
        const uint2 xw = xr[r + j];
        acc[0] += ws[j][0] * u_as_f(xw.x << 16); acc[1] += ws[j][1] * u_as_f(xw.x & 0xFFFF0000u);
        acc[2] += ws[j][2] * u_as_f(xw.y << 16); acc[3] += ws[j][3] * u_as_f(xw.y & 0xFFFF0000u);
      }
      uint2 w; w.x = pg8::cvt_pk_bf16(acc[0], acc[1]); w.y = pg8::cvt_pk_bf16(acc[2], acc[3]);
      *(uint2*)(dst + (long)r * 256) = w;
    }
  }
}


__device__ __forceinline__ void hidout_phase(const Params& p, const int e, LAS unsigned char* lds, const int tid, const int first, const int step) {
  LAS float* hs = (LAS float*)lds;
  const int eo = tid & 127, rl = tid >> 7;
  for (int r4 = first; r4 < 2 * NB * 4 * NCMP / 4; r4 += step) {
    const int r = r4 * 4 + rl;
    const int n = r % NCMP, rb = r / NCMP, kv = rb / (NB * 4), bg = rb % (NB * 4);
    const float* z = p.ZC + ((long)rb * 128 + n) * 256;
    hs[tid] = fsilu_(z[eo] + z[256 + 128 + eo] + p.C1[(e * 2 + kv) * 128 + eo]);
    __syncthreads();
    const float* w2 = (kv ? p.cmp_w2_v : p.cmp_w2_k) + (long)e * 128 * 128;
    float acc = 0.f;
#pragma unroll 8
    for (int i = 0; i < 128; ++i) acc += hs[rl * 128 + i] * w2[i * 128 + eo];
    if (kv) p.VCT[((long)bg * 128 + eo) * 128 + n] = f2bf(acc); else p.KCb[((long)bg * 128 + n) * 128 + eo] = f2bf(acc);
    if (n == 0) { if (kv) p.VCT[((long)bg * 128 + eo) * 128 + 127] = 0; else p.KCb[((long)bg * 128 + 127) * 128 + eo] = 0; }
    __syncthreads();
  }
}


__device__ __forceinline__ void unpack4(const uint2 w, float (&f)[4]) {
  f[0] = u_as_f(w.x << 16); f[1] = u_as_f(w.x & 0xFFFF0000u); f[2] = u_as_f(w.y << 16); f[3] = u_as_f(w.y & 0xFFFF0000u);
}
__device__ __forceinline__ void scan1_phase(const Params& p, const int tid) {
  for (int i = blockIdx.x * NTHREADS + tid; i < NB * 32 * 640; i += NBLK * NTHREADS) {
    const int cq = i % 640, r = i / 640, ch = r & 31, b = r >> 5;
    const long base = ((long)b * T_ + ch * 64) * DR + 4 * cq;
    float h[4] = {0.f, 0.f, 0.f, 0.f}, sl[4] = {0.f, 0.f, 0.f, 0.f};
#pragma unroll 16
    for (int t = 0; t < 64; ++t) {
      float la[4], uu[4];
      unpack4(*(const uint2*)(p.LA + base + (long)t * DR), la);
      unpack4(*(const uint2*)(p.UB + base + (long)t * DR), uu);
#pragma unroll
      for (int j = 0; j < 4; ++j) { h[j] = fexp_(la[j]) * h[j] + uu[j]; sl[j] += la[j]; }
    }
    const long so = ((long)b * 32 + ch) * DR + 4 * cq;
    *(f32x4*)(p.SUMP + so) = (f32x4){fexp_(sl[0]), fexp_(sl[1]), fexp_(sl[2]), fexp_(sl[3])};
    *(f32x4*)(p.SUMH + so) = (f32x4){h[0], h[1], h[2], h[3]};
  }
}
__device__ __forceinline__ void scan2_phase(const Params& p, const int tid) {
  for (int i = blockIdx.x * NTHREADS + tid; i < NB * 32 * 640; i += NBLK * NTHREADS) {
    const int cq = i % 640, r = i / 640, ch = r & 31, b = r >> 5;
    float h[4] = {0.f, 0.f, 0.f, 0.f};
#pragma unroll 8
    for (int cc = 0; cc < ch; ++cc) {
      const long so = ((long)b * 32 + cc) * DR + 4 * cq;
      const f32x4 P = *(const f32x4*)(p.SUMP + so), H = *(const f32x4*)(p.SUMH + so);
#pragma unroll
      for (int j = 0; j < 4; ++j) h[j] = P[j] * h[j] + H[j];
    }
    const long base = ((long)b * T_ + ch * 64) * DR + 4 * cq;
#pragma unroll 1
    for (int t0 = 0; t0 < 64; t0 += 16) {
      uint2 lav[16], uuv[16], gsv[16];
#pragma unroll
      for (int t = 0; t < 16; ++t) {
        lav[t] = *(const uint2*)(p.LA + base + (long)(t0 + t) * DR);
        uuv[t] = *(const uint2*)(p.UB + base + (long)(t0 + t) * DR);
        gsv[t] = *(const uint2*)(p.GS + base + (long)(t0 + t) * DR);
      }
#pragma unroll
      for (int t = 0; t < 16; ++t) {
        float la[4], uu[4], gs[4];
        unpack4(lav[t], la); unpack4(uuv[t], uu); unpack4(gsv[t], gs);
#pragma unroll
        for (int j = 0; j < 4; ++j) h[j] = fexp_(la[j]) * h[j] + uu[j];
        uint2 w; w.x = pg8::cvt_pk_bf16(h[0] * gs[0], h[1] * gs[1]); w.y = pg8::cvt_pk_bf16(h[2] * gs[2], h[3] * gs[3]);
        *(uint2*)(p.Ymix + base + (long)(t0 + t) * DR) = w;
      }
    }
  }
}

#define XB_TMO      128
#define XB_XCNT(j)  (256  + 64 * (j))
#define XB_XSUB(j)  (1280 + 64 * (j))
#define XB_XGEN(j)  (2304 + 64 * (j))
#define XB_TOP      3328
#define XB_TOPGEN   3392
#define XCD_BAR_WORDS 3456
#define XB_SPIN_CAP (1u << 20)
__device__ __forceinline__ unsigned xb_ld(unsigned* p)              { return __hip_atomic_load(p, __ATOMIC_RELAXED, __HIP_MEMORY_SCOPE_AGENT); }
__device__ __forceinline__ unsigned xb_add(unsigned* p, unsigned v) { return __hip_atomic_fetch_add(p, v, __ATOMIC_RELAXED, __HIP_MEMORY_SCOPE_AGENT); }
__device__ __forceinline__ unsigned xb_xcc_id() { return (unsigned)__builtin_amdgcn_s_getreg((3 << 11) | 20) & 0xFu; }
#define XB_SPIN(cond, bar) do { unsigned _sp = 0; while (cond) { __builtin_amdgcn_s_sleep(1); \
    if ((++_sp & 255u) == 0u) { if (xb_ld(&(bar)[XB_TMO])) break; if (_sp > XB_SPIN_CAP) { atomicAdd(&(bar)[XB_TMO], 1u); break; } } } } while (0)

__device__ __forceinline__ void xcd_barrier_complete(unsigned* bar, unsigned x, unsigned& nloc, unsigned& nx, const unsigned G) {
  unsigned sum, cnt, mine, sp = 0u;
  for (;;) {
    sum = 0u; cnt = 0u; mine = 0u;
#pragma unroll
    for (unsigned j = 0; j < 16; ++j) { const unsigned c = xb_ld(&bar[XB_XCNT(j)]); sum += c; cnt += (c > 0u) ? 1u : 0u; mine = (j == x) ? c : mine; }
    if (sum == G) break;
    __builtin_amdgcn_s_sleep(1);
    if ((++sp & 255u) == 0u) { if (xb_ld(&bar[XB_TMO])) break; if (sp > XB_SPIN_CAP) { atomicAdd(&bar[XB_TMO], 1u); break; } }
  }
  nloc = mine > 0u ? mine : 1u; nx = cnt > 0u ? cnt : 1u;
}
__device__ __forceinline__ void xcd_barrier(unsigned* bar, volatile LAS unsigned* st, const bool leader, const unsigned G) {
  asm volatile("s_waitcnt vmcnt(0)" ::: "memory");
  __syncthreads();
  if (leader) {
    const unsigned x = xb_xcc_id();
    __builtin_amdgcn_s_waitcnt(0);
    unsigned nloc = st[0], nx = st[1];
    if (nloc == 0u) { xcd_barrier_complete(bar, x, nloc, nx, G); st[0] = nloc; st[1] = nx; }
    const unsigned old = xb_add(&bar[XB_XSUB(x)], 1u);
    const unsigned gen = old / nloc;
    if (old + 1u == (gen + 1u) * nloc) {
      __builtin_amdgcn_fence(__ATOMIC_RELEASE, "agent");
      asm volatile("s_waitcnt vmcnt(0)" ::: "memory");
      const unsigned og = xb_add(&bar[XB_TOP], 1u);
      const unsigned tg = og / nx;
      if (og + 1u == (tg + 1u) * nx) xb_add(&bar[XB_TOPGEN], 1u);
      else XB_SPIN(xb_ld(&bar[XB_TOPGEN]) == tg, bar);
      __builtin_amdgcn_fence(__ATOMIC_ACQUIRE, "agent");
      xb_add(&bar[XB_XGEN(x)], 1u);
      asm volatile("s_waitcnt vmcnt(0)" ::: "memory");
    } else {
      XB_SPIN(xb_ld(&bar[XB_XGEN(x)]) == gen, bar);
      __builtin_amdgcn_fence(__ATOMIC_ACQUIRE, "agent");
      asm volatile("s_waitcnt vmcnt(0)" ::: "memory");
    }
  }
  __syncthreads();
}

__global__ void __launch_bounds__(NTHREADS, 2) mega(Params p_unused) {
  extern __shared__ __attribute__((aligned(16))) unsigned char lds[];

  const int wid_s = __builtin_amdgcn_readfirstlane((int)(threadIdx.x >> 6));
  const int bid_s = __builtin_amdgcn_readfirstlane((int)blockIdx.x);
  volatile LAS unsigned* bar_st = (volatile LAS unsigned*)((LAS unsigned char*)lds + LDS_BYTES - 16);
  volatile LAS unsigned* bar_st2 = (volatile LAS unsigned*)((LAS unsigned char*)lds + LDS_BYTES - 32);
  if (threadIdx.x == 0) { bar_st[0] = 0u; bar_st[1] = 0u; bar_st2[0] = 0u; bar_st2[1] = 0u; }
  __syncthreads();
  { const Params p = *kparams(); if (threadIdx.x == 0) { (void)xb_add(&p.BAR[XB_XCNT(xb_xcc_id())], 1u); if (bid_s >= 64) (void)xb_add(&p.BAR[XCD_BAR_WORDS + XB_XCNT(xb_xcc_id())], 1u); } }
#ifdef PROFILE_LEAK
  volatile LAS unsigned* prof = (volatile LAS unsigned*)((LAS unsigned char*)lds + LDS_BYTES - 128);
  if (threadIdx.x < 16) prof[threadIdx.x] = 0u;
  unsigned long long t_prev = __builtin_amdgcn_s_memrealtime();
  int cat_ = 0;
#define CAT(c) cat_ = (c)
#define GSYNC() do { const Params pb_ = *kparams(); xcd_barrier(pb_.BAR, bar_st, wid_s == 0 && opaque_lane() == 0, NBLK); \
    { const unsigned long long tn_ = __builtin_amdgcn_s_memrealtime(); if (wid_s == 0 && opaque_lane() == 0) prof[cat_] += (unsigned)(tn_ - t_prev); t_prev = tn_; } } while (0)
#else
#define CAT(c)
#define GSYNC() do { const Params pb_ = *kparams(); xcd_barrier(pb_.BAR, bar_st, wid_s == 0 && opaque_lane() == 0, NBLK); } while (0)
#endif
#define GSYNC_N() do { const Params pb_ = *kparams(); xcd_barrier(pb_.BAR + XCD_BAR_WORDS, bar_st2, wid_s == 0 && opaque_lane() == 0, 192u); } while (0)
#define RUN(kind, layer) do { const Params p = *kparams(); const int tid = opaque_tid(); const long n_ = stage_threads(kind); \
    for (long g_ = (long)bid_s * NTHREADS + tid; g_ < n_; g_ += (long)NBLK * NTHREADS) stage_thread(p, kind, layer, g_); GSYNC(); } while (0)
  {
    const Params p = *kparams(); const int tid = opaque_tid();
    float* tile = (float*)lds;
    const int nb = NBLK, bid = bid_s;
    wt_convert256(p.even_w_in, p.Wt_ein, D_, EIN, EIN_PAD, tile, bid, nb, tid);
    for (int l = 0; l < 2; ++l)
      for (int kv = 0; kv < 2; ++kv) {
        const float* w1 = (kv ? p.cmp_w1_v : p.cmp_w1_k) + (size_t)l * 4096 * 128;
        bf16_t* dst = p.W1T + (size_t)(l * 2 + kv) * 256 * 2048;
        wt_convert(w1, dst, 2048, 128, 128, tile, bid, nb, tid);
        wt_convert(w1 + (size_t)2048 * 128, dst + (size_t)128 * 2048, 2048, 128, 128, tile, bid, nb, tid);
      }
  }
  CAT(1);
  { const Params p = *kparams(); const int tid = opaque_tid(); c1_phase(p, tid, wid_s);
    const long n_ = stage_threads(SK_WG);
    for (long g_ = (long)bid_s * NTHREADS + tid; g_ < n_; g_ += (long)NBLK * NTHREADS) stage_thread(p, SK_WG, 0, g_);
    rmsnorm_phase<false, true>(p.x, p.X, p.norm_w, p.Hb, nullptr, tid, wid_s); }
  GSYNC();
#define LAYER_PAIR(e) { \
    const int le = 2 * e, lo = 2 * e + 1; \
    CAT(3); \
    { const Params p = *kparams(); pg8::Gemm g{p.Hb, p.Wt_ein + (size_t)e * EIN_PAD * D_, M_, EIN_PAD, D_}; pg8::StaticOrder S; S.init(M_, EIN_PAD, NBLK, bid_s); EpiEvenIn E{p.QS, p.LF, p.KK, p.AVT, p.LB + e * 2048, p.PB, p.VT, p.KVC}; \
      pg8::gemm_phase<EpiEvenIn, pg8::StaticOrder, GEMM_ALIGN, SP2_EIN>((LAS unsigned char*)lds, g, S, E, wid_s); } \
    if (bid_s >= 160) { const Params p = *kparams(); const int tid = opaque_tid(); float* tile = (float*)lds;     \
      if (e == 0) { \
        wt_convert256(p.even_w_out, p.Wt_eout, 4096, D_, D_, tile, bid_s - 160, 96, tid); \
        wt_convert256(p.odd_w_in, p.Wt_oin, D_, OIN, OIN, tile, bid_s - 160, 96, tid); \
        wt_convert256(p.odd_w_out, p.Wt_oout, DR, D_, D_, tile, bid_s - 160, 96, tid); \
      } else { \
        wt_convert256(p.odd_w_in + (size_t)D_ * OIN, p.Wt_oin + (size_t)OIN * D_, D_, OIN, OIN, tile, bid_s - 160, 96, tid); \
        wt_convert256(p.odd_w_out + (size_t)DR * D_, p.Wt_oout + (size_t)D_ * DR, DR, D_, D_, tile, bid_s - 160, 96, tid); \
      } } \
    GSYNC(); CAT(4); \
    if (bid_s < 64) { const Params p = *kparams(); const int tid = opaque_tid(); hgrn_full_phase(p, e, (LAS unsigned char*)lds, tid, wid_s); } \
    else { \
      if (bid_s < 80) { const Params p = *kparams(); pg8::Gemm g{p.KVC, p.W1T + (size_t)e * 2 * 256 * 2048, 2 * NB * 4 * 128, 512, 2048}; CmpOrder S{16, bid_s - 64}; EpiZ E{p.ZC}; \
        pg8::gemm_phase<EpiZ, CmpOrder, GEMM_ALIGN, SP2_CMP>((LAS unsigned char*)lds, g, S, E, wid_s); } \
      else { const Params p = *kparams(); const int tid = opaque_tid(); attn_phase<0>(p, (LAS unsigned char*)lds, tid); } \
      GSYNC_N(); \
      { const Params p = *kparams(); const int tid = opaque_tid(); hidout_phase(p, e, (LAS unsigned char*)lds, tid, bid_s - 64, 192); } \
      GSYNC_N(); \
      { const Params p = *kparams(); const int tid = opaque_tid(); cmp_phase(p, (LAS unsigned char*)lds, tid, wid_s, bid_s - 64, 192); } \
    } \
    GSYNC(); CAT(9); \
    { const Params p = *kparams(); const int tid = opaque_tid(); attn_phase<1>(p, (LAS unsigned char*)lds, tid); } \
    GSYNC(); CAT(10); \
    { const Params p = *kparams(); pg8::Gemm g{p.Ymix, p.Wt_eout + (size_t)e * D_ * 4096, M_, D_, 4096}; pg8::StaticOrder S; S.init(M_, D_, NBLK, bid_s); EpiAccumF32 E{p.X, D_}; \
      pg8::gemm_phase<EpiAccumF32, pg8::StaticOrder, GEMM_ALIGN, SP2_OUT>((LAS unsigned char*)lds, g, S, E, wid_s); } \
    GSYNC(); CAT(2); \
    { const Params p = *kparams(); const int tid = opaque_tid(); rmsnorm_phase<false, false>(p.X, nullptr, p.norm_w + lo * D_, p.Hb, nullptr, tid, wid_s); } \
    GSYNC(); CAT(11); \
    { const Params p = *kparams(); pg8::Gemm g{p.Hb, p.Wt_oin + (size_t)e * OIN * D_, M_, OIN, D_}; pg8::StaticOrder S; S.init(M_, OIN, NBLK, bid_s); EpiOddIn E{p.XB, p.GS}; \
      pg8::gemm_phase<EpiOddIn, pg8::StaticOrder, GEMM_ALIGN, SP2_OIN>((LAS unsigned char*)lds, g, S, E, wid_s); } \
    if (e == 0 && bid_s >= 128) { const Params p = *kparams(); const int tid = opaque_tid(); float* tile = (float*)lds; \
      wt_convert256(p.even_w_in + (size_t)D_ * EIN, p.Wt_ein + (size_t)EIN_PAD * D_, D_, EIN, EIN_PAD, tile, bid_s - 128, 128, tid); \
      wt_convert256(p.even_w_out + (size_t)4096 * D_, p.Wt_eout + (size_t)D_ * 4096, 4096, D_, D_, tile, bid_s - 128, 128, tid); } \
    GSYNC(); CAT(12); \
    { const Params p = *kparams(); const int tid = opaque_tid(); conv_phase(p, e, tid); } \
    GSYNC(); CAT(13); \
    { const Params p = *kparams(); pg8::Gemm g{p.XCb, p.Wt_g + (size_t)e * 10 * 2 * 256 * 256, 10 * M_, 5120, 256}; DiagOrder S{NBLK, bid_s}; \
      EpiGates E{p.XCb, p.rg_b_a + e * DR, p.rg_b_i + e * DR, p.SP + e * DR, p.LA, p.UB}; \
      pg8::gemm_phase<EpiGates, DiagOrder, GEMM_ALIGN, SP2_GATES>((LAS unsigned char*)lds, g, S, E, wid_s); } \
    GSYNC(); CAT(14); \
    { const Params p = *kparams(); const int tid = opaque_tid(); scan1_phase(p, tid); } \
    GSYNC(); \
    { const Params p = *kparams(); const int tid = opaque_tid(); scan2_phase(p, tid); } \
    GSYNC(); CAT(15); \
    { const Params p = *kparams(); pg8::Gemm g{p.Ymix, p.Wt_oout + (size_t)e * D_ * DR, M_, D_, DR}; pg8::StaticOrder S; S.init(M_, D_, NBLK, bid_s); EpiAccumF32 E{p.X, D_}; \
      pg8::gemm_phase<EpiAccumF32, pg8::StaticOrder, GEMM_ALIGN, SP2_OUT>((LAS unsigned char*)lds, g, S, E, wid_s); } \
    GSYNC(); CAT(2); \
    { const Params p = *kparams(); const int tid = opaque_tid(); \
      if (e == 0) rmsnorm_phase<false, false>(p.X, nullptr, p.norm_w + 2 * D_, p.Hb, nullptr, tid, wid_s); \
      else rmsnorm_phase<true, false>(p.X, nullptr, p.final_norm_w, nullptr, p.out, tid, wid_s); } \
    if (e == 0) GSYNC(); \
  }
  LAYER_PAIR(0)
  LAYER_PAIR(1)
#undef LAYER_PAIR
#ifdef PROFILE_LEAK
  { __syncthreads();
    unsigned long long tsum_ = 0; for (int c_ = 0; c_ < 16; ++c_) if ((LEAK_DUR_MASK >> c_) & 1) tsum_ += prof[c_];
    const unsigned long long t_end = __builtin_amdgcn_s_memrealtime() + 2ull * tsum_;
    while (__builtin_amdgcn_s_memrealtime() < t_end) __builtin_amdgcn_s_sleep(8); }
#endif
#undef RUN
#undef GSYNC
}

static size_t carve(size_t& off, size_t bytes) { size_t o = off; off += (bytes + 255) & ~(size_t)255; return o; }

extern "C" void kernel_launch(void* const* d_in, const int* in_sizes, int n_in, void* d_out, int out_size, void* d_ws,
                              size_t ws_size, hipStream_t stream) {
  Params p{};
  {
    const float* ins[22];
    for (int i = 0; i < 22; ++i) ins[i] = (const float*)d_in[i];
    p.x = ins[0]; p.norm_w = ins[1]; p.final_norm_w = ins[2]; p.even_w_in = ins[3]; p.even_w_out = ins[4];
    p.hgrn_lb_logits = ins[5]; p.hgrn_norm_w = ins[6]; p.cmp_pe_k = ins[7]; p.cmp_w1_k = ins[8]; p.cmp_w2_k = ins[9];
    p.cmp_pe_v = ins[10]; p.cmp_w1_v = ins[11]; p.cmp_w2_v = ins[12]; p.odd_w_in = ins[13]; p.odd_w_out = ins[14];
    p.rg_conv_w = ins[15]; p.rg_conv_b = ins[16]; p.rg_w_a = ins[17]; p.rg_b_a = ins[18]; p.rg_w_i = ins[19];
    p.rg_b_i = ins[20]; p.rg_lambda = ins[21];
  }
  p.out = (float*)d_out;
  char* ws = (char*)d_ws;
  size_t off = 0;
  p.BAR = (unsigned*)(ws + carve(off, 2 * XCD_BAR_WORDS * 4));
  p.X = (float*)(ws + carve(off, (size_t)M_ * D_ * 4));
  p.Hb = (bf16_t*)(ws + carve(off, (size_t)M_ * D_ * 2));
  p.Wt_ein = (bf16_t*)(ws + carve(off, 2ull * EIN_PAD * D_ * 2));
  p.Wt_eout = (bf16_t*)(ws + carve(off, 2ull * D_ * 4096 * 2));
  p.Wt_oin = (bf16_t*)(ws + carve(off, 2ull * OIN * D_ * 2));
  p.Wt_oout = (bf16_t*)(ws + carve(off, 2ull * D_ * DR * 2));
  p.QS = (bf16_t*)(ws + carve(off, (size_t)M_ * 2048 * 2));
  p.XB = p.QS;
  p.GS = p.XB + (size_t)M_ * DR; p.LA = p.GS + (size_t)M_ * DR; p.UB = p.LA + (size_t)M_ * DR;
  p.LF = (float*)(ws + carve(off, (size_t)M_ * 2048 * 4));
  p.KK = (bf16_t*)(ws + carve(off, (size_t)M_ * 2048 * 2));
  p.AVT = (bf16_t*)(ws + carve(off, (size_t)M_ * 2048 * 2));
  p.LB = (float*)(ws + carve(off, 2 * 2048 * 4));
  p.KVC = (bf16_t*)(ws + carve(off, 2ull * NB * 4 * T_ * 128 * 2));
  p.W1T = (bf16_t*)(ws + carve(off, 2ull * 2 * 256 * 2048 * 2));
  p.ZC = (float*)(ws + carve(off, 2ull * NB * 4 * 128 * 256 * 4));
  p.C1 = (float*)(ws + carve(off, 2 * 2 * 128 * 4));
  p.KCb = (bf16_t*)(ws + carve(off, (size_t)NB * 4 * 128 * 128 * 2));
  p.VCT = (bf16_t*)(ws + carve(off, (size_t)NB * 4 * 128 * 128 * 2));
  p.Ymix = (bf16_t*)(ws + carve(off, (size_t)M_ * 4096 * 2));
  p.RS = (float*)(ws + carve(off, (size_t)M_ * 16 * 4));
  p.HID = (float*)(ws + carve(off, 2ull * NB * 4 * NCMP * 128 * 4));
  p.KC = (float*)(ws + carve(off, (size_t)NB * 4 * NCMP * 128 * 4));
  p.VC = (float*)(ws + carve(off, (size_t)NB * 4 * NCMP * 128 * 4));
  p.IMP = (float*)(ws + carve(off, (size_t)M_ * 4 * 32 * 4));
  p.SELM = (int*)(ws + carve(off, (size_t)M_ * 4 * 4));
  p.VT = (bf16_t*)(ws + carve(off, 2ull * NB * 4 * 128 * T_ * 2));
  p.Wt_g = (bf16_t*)(ws + carve(off, 2ull * 10 * 2 * 256 * 256 * 2));
  p.SP = (float*)(ws + carve(off, 2ull * DR * 4));
  size_t shared0 = off;
  p.PB = (bf16_t*)(ws + carve(off, (size_t)M_ * PB_W * 2));
  p.OA = (float*)(ws + carve(off, (size_t)M_ * 2048 * 4));
  p.PCMP = (float*)(ws + carve(off, (size_t)M_ * 16 * 128 * 4));
  p.YB = (float*)(ws + carve(off, (size_t)M_ * 2048 * 4));
  size_t end_even = off;
  off = shared0;
  p.XC = nullptr;
  p.XCb = (bf16_t*)(ws + carve(off, (size_t)M_ * DR * 2));
  p.SUMP = (float*)(ws + carve(off, (size_t)NB * 32 * DR * 4));
  p.SUMH = (float*)(ws + carve(off, (size_t)NB * 32 * DR * 4));
  if (off < end_even) off = end_even;
  if (off > ws_size) { fprintf(stderr, "workspace too small: need %zu have %zu\n", off, ws_size); return; }

  static int grid_blocks = 0;
  if (!grid_blocks) {
    int dev = 0, cus = 0, per_cu = 0;
    (void)hipGetDevice(&dev);
    (void)hipDeviceGetAttribute(&cus, hipDeviceAttributeMultiprocessorCount, dev);
    (void)hipFuncSetAttribute((const void*)mega, hipFuncAttributeMaxDynamicSharedMemorySize, LDS_BYTES);
    (void)hipOccupancyMaxActiveBlocksPerMultiprocessor(&per_cu, mega, NTHREADS, LDS_BYTES);
    if (per_cu < 1) fprintf(stderr, "occupancy query reports %d blocks/CU\n", per_cu);
    (void)hipGetLastError();
    if (cus < NBLK) fprintf(stderr, "device has %d CUs, kernel needs %d resident workgroups\n", cus, NBLK);
    grid_blocks = NBLK;
  }
  (void)hipMemsetAsync(p.BAR, 0, 2 * XCD_BAR_WORDS * 4, stream);
  hipLaunchKernelGGL(mega, dim3(grid_blocks), dim3(NTHREADS), LDS_BYTES, stream, p);
}
#endif
```

```cpp
#ifndef CPU_SHIM
#include <hip/hip_runtime.h>
#include <hip/hip_cooperative_groups.h>
#include <cstdio>
namespace cg = cooperative_groups;
#define DEVI __device__ __forceinline__
#else
#include <cmath>
#include <cstring>
#include <cstdio>
#include <cstdlib>
#define DEVI static inline
#endif

#ifndef NB
#define NB 4
#endif

typedef unsigned short bf16_t;

constexpr int T_ = 2048;
constexpr int D_ = 2048;
constexpr int M_ = NB * T_;
constexpr int EIN = 15408;
constexpr int EIN_PAD = 15616;
constexpr int OIN = 5120;
constexpr int PA_W = 6144;
constexpr int PB_W = EIN_PAD - PA_W;
constexpr int DR = 2560;
constexpr int C_AQ = 0, C_AF = 2048, C_AI = 4096, C_AG = 6144, C_BQ = 8192, C_KC = 10240, C_VC = 10752,
              C_KS = 11264, C_VS = 11776, C_KW = 12288, C_VW = 12800, C_GT = 13312, C_BG = 13360;
constexpr int NCMP = 127;
constexpr float NORM_EPS = 1e-6f;

DEVI unsigned f_as_u(float f) {
#ifndef CPU_SHIM
  return __float_as_uint(f);
#else
  unsigned u; memcpy(&u, &f, 4); return u;
#endif
}
DEVI float u_as_f(unsigned u) {
#ifndef CPU_SHIM
  return __uint_as_float(u);
#else
  float f; memcpy(&f, &u, 4); return f;
#endif
}
DEVI bf16_t f2bf(float f) {
  unsigned u = f_as_u(f);
  u += 0x7FFFu + ((u >> 16) & 1u);
  return (bf16_t)(u >> 16);
}
DEVI float bf2f(bf16_t h) { return u_as_f(((unsigned)h) << 16); }
DEVI float sigmoidf_(float x) { return 1.0f / (1.0f + expf(-x)); }
DEVI float siluf_(float x) { return x / (1.0f + expf(-x)); }
DEVI float softplusf_(float x) { return x > 20.f ? x : log1pf(expf(x)); }

struct Params;

struct Params {
  const float *x, *norm_w, *final_norm_w, *even_w_in, *even_w_out, *hgrn_lb_logits, *hgrn_norm_w,
      *cmp_pe_k, *cmp_w1_k, *cmp_w2_k, *cmp_pe_v, *cmp_w1_v, *cmp_w2_v, *odd_w_in, *odd_w_out,
      *rg_conv_w, *rg_conv_b, *rg_w_a, *rg_b_a, *rg_w_i, *rg_b_i, *rg_lambda;
  float* out;
  float* X;
  bf16_t* Hb;
  bf16_t* Wt_ein;
  bf16_t* Wt_eout;
  bf16_t* Wt_oin;
  bf16_t* Wt_oout;
  bf16_t* QS;
  float* LF;
  bf16_t* KK;
  bf16_t* AVT;
  float* LB;
  unsigned* BAR;
  bf16_t* KVC;
  bf16_t* W1T;
  float* ZC;
  float* C1;
  bf16_t* KCb;
  bf16_t* VCT;
  bf16_t* PB;
  bf16_t* XB;
  bf16_t* GS;
  bf16_t* LA;
  bf16_t* UB;
  float* SUMP;
  float* SUMH;
  bf16_t* Ymix;
  float* RS;
  float* HID;
  float* KC;
  float* VC;
  float* IMP;
  int* SELM;
  float* OA;
  float* PCMP;
  float* YB;
  bf16_t* VT;
  float* XC;
  bf16_t* XCb;
  float* SP;
  bf16_t* Wt_g;
  float* AA;
  float* UU;
};


DEVI float pbv(const Params& p, long row, int col) { return bf2f(p.PB[row * PB_W + (col - PA_W)]); }

constexpr long N_WT = 2L * EIN_PAD * D_ + 2L * D_ * 4096 + 2L * OIN * D_ + 2L * D_ * DR;

DEVI void st_wt(const Params& p, long g) {
  const long n0 = 2L * EIN_PAD * D_, n1 = 2L * D_ * 4096, n2 = 2L * OIN * D_;
  if (g < n0) {
    int e = (int)(g / ((long)EIN_PAD * D_)); long r = g % ((long)EIN_PAD * D_);
    int n = (int)(r / D_), k = (int)(r % D_);
    float v = n < EIN ? p.even_w_in[((long)e * D_ + k) * EIN + n] : 0.f;
    p.Wt_ein[g] = f2bf(v);
    return;
  }
  g -= n0;
  if (g < n1) {
    int e = (int)(g / ((long)D_ * 4096)); long r = g % ((long)D_ * 4096);
    int n = (int)(r / 4096), k = (int)(r % 4096);
    p.Wt_eout[g] = f2bf(p.even_w_out[((long)e * 4096 + k) * D_ + n]);
    return;
  }
  g -= n1;
  if (g < n2) {
    int e = (int)(g / ((long)OIN * D_)); long r = g % ((long)OIN * D_);
    int n = (int)(r / D_), k = (int)(r % D_);
    p.Wt_oin[g] = f2bf(p.odd_w_in[((long)e * D_ + k) * OIN + n]);
    return;
  }
  g -= n2;
  {
    int e = (int)(g / ((long)D_ * DR)); long r = g % ((long)D_ * DR);
    int n = (int)(r / DR), k = (int)(r % DR);
    p.Wt_oout[g] = f2bf(p.odd_w_out[((long)e * DR + k) * D_ + n]);
  }
}

DEVI void st_copy(const Params& p, long g) { p.X[g] = p.x[g]; }

DEVI void st_rowss(const Params& p, long g) {
  const float* r = p.X + g * 128;
  float s = 0.f;
  for (int i = 0; i < 128; ++i) s += r[i] * r[i];
  p.RS[g] = s;
}
DEVI float row_rstd(const Params& p, long row) {
  float s = 0.f;
  for (int i = 0; i < 16; ++i) s += p.RS[row * 16 + i];
  return 1.0f / sqrtf(s * (1.0f / D_) + NORM_EPS);
}
DEVI void st_norm(const Params& p, int layer, long g) {
  long row = g / D_; int c = (int)(g % D_);
  p.Hb[g] = f2bf(p.X[g] * row_rstd(p, row) * p.norm_w[layer * D_ + c]);
}
DEVI void st_final(const Params& p, long g) {
  long row = g / D_; int c = (int)(g % D_);
  p.out[g] = p.X[g] * row_rstd(p, row) * p.final_norm_w[c];
}


DEVI void st_hgrn_rec2(const Params& p, long g) {
  int v = (int)(g % 128); int h = (int)((g / 128) % 16); int b = (int)(g / 2048);
  float S[128];
#pragma unroll
  for (int k = 0; k < 128; ++k) S[k] = 0.f;
  for (int t = 0; t < T_; ++t) {
    long row = (long)b * T_ + t;
    const bf16_t* qf = p.QS + row * 2048 + h * 128;
    const float* lf = p.LF + row * 2048 + h * 128;
    const bf16_t* kk = p.KK + row * 2048 + h * 128;
    float vv = bf2f(p.AVT[(((long)b * 16 + h) * 128 + v) * T_ + t]);
    float o = 0.f;
#pragma unroll
    for (int k = 0; k < 128; ++k) {
      float f = expf(lf[k]);
      S[k] = f * S[k] + bf2f(kk[k]) * vv;
      o += bf2f(qf[k]) * S[k];
#ifndef CPU_SHIM
      if ((k & 15) == 15) asm volatile("" ::: "memory");
#endif
    }
    p.OA[row * 2048 + h * 128 + v] = o;
  }
}
DEVI void st_hgrn_post(const Params& p, int e, long g) {
  long row = g / 16; int h = (int)(g % 16);
  const float* o = p.OA + row * 2048 + h * 128;
  float s = 0.f;
  for (int i = 0; i < 128; ++i) s += o[i] * o[i];
  float rstd = 1.0f / sqrtf(s * (1.0f / 128) + NORM_EPS);
  for (int i = 0; i < 128; ++i) {
    int c = h * 128 + i;
    float y = o[i] * rstd * p.hgrn_norm_w[e * 2048 + c] * siluf_(pbv(p, row, C_AG + c));
    p.Ymix[row * 4096 + c] = f2bf(y);
  }
}

DEVI void st_cmp_hid(const Params& p, int e, long g) {
  int eo = (int)(g % 128); long r = g / 128;
  int n = (int)(r % NCMP); r /= NCMP;
  int gg = (int)(r % 4); r /= 4;
  int b = (int)(r % NB); int kv = (int)(r / NB);
  const float* pe = (kv ? p.cmp_pe_v : p.cmp_pe_k) + (long)e * 32 * 128;
  const float* w1 = (kv ? p.cmp_w1_v : p.cmp_w1_k) + (long)e * 4096 * 128;
  int col = (kv ? C_VC : C_KC) + gg * 128;
  float acc = 0.f;
  for (int j = 0; j < 32; ++j) {
    const long srow = (long)b * T_ + 16 * n + j;
    for (int d = 0; d < 128; ++d) acc += (pbv(p, srow, col + d) + pe[j * 128 + d]) * w1[(long)(j * 128 + d) * 128 + eo];
  }
  p.HID[g] = siluf_(acc);
}

DEVI void st_cmp_hid2(const Params& p, int e, long g) {
  int eo = (int)(g % 128); long r = g / 128;
  int n = (int)(r % NCMP); r /= NCMP;
  int kv = (int)(r / (NB * 4));
  const float* z = p.ZC + (r * 128 + n) * 256;
  float acc = z[eo] + z[256 + 128 + eo] + p.C1[(e * 2 + kv) * 128 + eo];
  p.HID[g] = siluf_(acc);
}

DEVI void st_cmp_hidout(const Params& p, int e, long g) {
  int eo = (int)(g % 128); long r = g / 128;
  int n = (int)(r % NCMP); long rb = r / NCMP;
  int kv = (int)(rb / (NB * 4));
  const float* z = p.ZC + (rb * 128 + n) * 256;
  const float* c1 = p.C1 + (e * 2 + kv) * 128;
  const float* w2 = (kv ? p.cmp_w2_v : p.cmp_w2_k) + (long)e * 128 * 128;
  float acc = 0.f;
  for (int i = 0; i < 128; ++i) acc += siluf_(z[i] + z[256 + 128 + i] + c1[i]) * w2[i * 128 + eo];
  long bg = rb % (NB * 4);
  if (kv) p.VCT[(bg * 128 + eo) * 128 + n] = f2bf(acc); else p.KCb[(bg * 128 + n) * 128 + eo] = f2bf(acc);
  if (n == 0) { if (kv) p.VCT[(bg * 128 + eo) * 128 + 127] = 0; else p.KCb[(bg * 128 + 127) * 128 + eo] = 0; }
}
DEVI void st_cmp_out(const Params& p, int e, long g) {
  int eo = (int)(g % 128); long r = g / 128;
  int kv = (int)(r / ((long)NCMP * 4 * NB));
  const float* w2 = (kv ? p.cmp_w2_v : p.cmp_w2_k) + (long)e * 128 * 128;
  const float* hid = p.HID + r * 128;
  float acc = 0.f;
  for (int i = 0; i < 128; ++i) acc += hid[i] * w2[i * 128 + eo];
  long half = (long)NB * 4 * NCMP * 128;
  if (kv) p.VC[g - half] = acc; else p.KC[g] = acc;
  {
    long rr = r % ((long)NCMP * 4 * NB);
    int n = (int)(rr % NCMP); long bg = rr / NCMP;
    if (kv) p.VCT[(bg * 128 + eo) * 128 + n] = f2bf(acc); else p.KCb[(bg * 128 + n) * 128 + eo] = f2bf(acc);
    if (n == 0) { if (kv) p.VCT[(bg * 128 + eo) * 128 + 127] = 0; else p.KCb[(bg * 128 + 127) * 128 + eo] = 0; }
  }
}

DEVI float alibi_slope(int head) { return exp2f(-0.5f * (float)(head + 1)); }

DEVI void st_cmp_attn(const Params& p, long g) {
  int t = (int)(g % T_); int head = (int)((g / T_) % 16); int b = (int)(g / ((long)T_ * 16));
  int gg = head >> 2;
  long row = (long)b * T_ + t;
  const float scale = 0.08838834764831845f;
  const float slope = alibi_slope(head);
  int nvalid = t < 31 ? 0 : ((t - 31) / 16 + 1);
  if (nvalid > NCMP) nvalid = NCMP;
  float* pc = p.PCMP + (row * 16 + head) * 128;
  const float* kc = p.KC + ((long)(b * 4 + gg) * NCMP) * 128;
  const float* vc = p.VC + ((long)(b * 4 + gg) * NCMP) * 128;
  float mx = -3.0e38f;
  {
    float q[128];
#pragma unroll
    for (int d = 0; d < 128; ++d) q[d] = pbv(p, row, C_BQ + head * 128 + d);
    for (int n = 0; n < nvalid; ++n) {
      float s = 0.f;
#pragma unroll
      for (int d = 0; d < 128; ++d) s += q[d] * kc[n * 128 + d];
      s = s * scale - slope * (float)(t - 16 * n - 31);
      pc[n] = s;
      mx = fmaxf(mx, s);
    }
  }
  float sum = 0.f;
  for (int n = 0; n < nvalid; ++n) { float e_ = expf(pc[n] - mx); pc[n] = e_; sum += e_; }
  float inv = nvalid > 0 ? 1.0f / sum : 0.f;
  float o[128];
#pragma unroll
  for (int d = 0; d < 128; ++d) o[d] = 0.f;
  for (int n = 0; n < nvalid; ++n) {
    float pn = pc[n] * inv;
    pc[n] = pn;
#pragma unroll
    for (int d = 0; d < 128; ++d) o[d] += pn * vc[n * 128 + d];
  }
  for (int n = nvalid; n < 128; ++n) pc[n] = 0.f;
  float* op = p.YB + row * 2048 + head * 128;
  const float g0 = sigmoidf_(pbv(p, row, C_GT + head * 3 + 0));
#pragma unroll
  for (int d = 0; d < 128; ++d) op[d] = g0 * o[d];
}

DEVI void st_imp(const Params& p, long g) {
  int j = (int)(g % 32); int gg = (int)((g / 32) % 4); long row = g / 128;
  int t = (int)(row % T_);
  int cur = t >> 6;
  int n0 = 4 * j - 1; if (n0 < 0) n0 = 0;
  int n1 = 4 * j + 3; if (n1 > NCMP - 1) n1 = NCMP - 1;
  float s = 0.f;
  for (int hh = 0; hh < 4; ++hh) {
    const float* pc = p.PCMP + (row * 16 + gg * 4 + hh) * 128;
    for (int n = n0; n <= n1; ++n) s += pc[n];
  }
  float sc;
  if (j == 0 || j == cur || j == cur - 1) sc = 1e30f;
  else if (j <= cur) sc = s;
  else sc = -1e30f;
  p.IMP[g] = sc;
}
DEVI void st_topk(const Params& p, long g) {
  const float* sc = p.IMP + g * 32;
  unsigned mask = 0;
  for (int j = 0; j < 32; ++j) {
    float sj = sc[j];
    int cnt = 0;
    for (int i = 0; i < 32; ++i) {
      float si = sc[i];
      cnt += (si > sj) || (si == sj && i < j);
    }
    if (cnt < 16) mask |= (1u << j);
  }
  p.SELM[g] = (int)mask;
}

DEVI void st_sel_attn(const Params& p, long g) {
  int vq = (int)(g & 3); long r = g >> 2;
  int t = (int)(r % T_); int head = (int)((r / T_) % 16); int b = (int)(r / ((long)T_ * 16));
  int gg = head >> 2;
  long row = (long)b * T_ + t;
  const float scale = 0.08838834764831845f;
  const float slope = alibi_slope(head);
  unsigned mask = (unsigned)p.SELM[row * 4 + gg];
  int cur = t >> 6;
  float q[128];
#pragma unroll
  for (int d = 0; d < 128; ++d) q[d] = pbv(p, row, C_BQ + head * 128 + d) * scale;
  float o[32];
#pragma unroll
  for (int d = 0; d < 32; ++d) o[d] = 0.f;
  float mx = -3.0e38f, l = 0.f;
  for (int j = 0; j <= cur; ++j) {
    if (!((mask >> j) & 1u)) continue;
    int kend = j * 64 + 63; if (kend > t) kend = t;
    for (int kp = j * 64; kp <= kend; ++kp) {
      const bf16_t* pk = p.PB + ((long)b * T_ + kp) * PB_W - PA_W;
      const bf16_t* kr = pk + C_KS + gg * 128;
      const bf16_t* vr = pk + C_VS + gg * 128 + vq * 32;
      float s = 0.f;
#pragma unroll
      for (int d = 0; d < 128; ++d) s += q[d] * bf2f(kr[d]);
      s -= slope * (float)(t - kp);
      if (s > mx) {
        float a = expf(mx - s);
        l *= a;
#pragma unroll
        for (int d = 0; d < 32; ++d) o[d] *= a;
        mx = s;
      }
      float pp = expf(s - mx);
      l += pp;
#pragma unroll
      for (int d = 0; d < 32; ++d) o[d] += pp * bf2f(vr[d]);
    }
  }
  float inv = sigmoidf_(pbv(p, row, C_GT + head * 3 + 1)) / l;
  float* op = p.YB + row * 2048 + head * 128 + vq * 32;
#pragma unroll
  for (int d = 0; d < 32; ++d) op[d] += o[d] * inv;
}

DEVI void st_win_attn(const Params& p, long g) {
  int vq = (int)(g & 3); long r = g >> 2;
  int t = (int)(r % T_); int head = (int)((r / T_) % 16); int b = (int)(r / ((long)T_ * 16));
  int gg = head >> 2;
  long row = (long)b * T_ + t;
  const float scale = 0.08838834764831845f;
  const float slope = alibi_slope(head);
  float q[128];
#pragma unroll
  for (int d = 0; d < 128; ++d) q[d] = pbv(p, row, C_BQ + head * 128 + d) * scale;
  float o[32];
#pragma unroll
  for (int d = 0; d < 32; ++d) o[d] = 0.f;
  float mx = -3.0e38f, l = 0.f;
  int k0 = t - 511; if (k0 < 0) k0 = 0;
  for (int kp = k0; kp <= t; ++kp) {
    const bf16_t* pk = p.PB + ((long)b * T_ + kp) * PB_W - PA_W;
    const bf16_t* kr = pk + C_KW + gg * 128;
    const bf16_t* vr = pk + C_VW + gg * 128 + vq * 32;
    float s = 0.f;
#pragma unroll
    for (int d = 0; d < 128; ++d) s += q[d] * bf2f(kr[d]);
    s -= slope * (float)(t - kp);
    if (s > mx) {
      float a = expf(mx - s);
      l *= a;
#pragma unroll
      for (int d = 0; d < 32; ++d) o[d] *= a;
      mx = s;
    }
    float pp = expf(s - mx);
    l += pp;
#pragma unroll
    for (int d = 0; d < 32; ++d) o[d] += pp * bf2f(vr[d]);
  }
  float inv = sigmoidf_(pbv(p, row, C_GT + head * 3 + 2)) / l;
  float* op = p.YB + row * 2048 + head * 128 + vq * 32;
#pragma unroll
  for (int d = 0; d < 32; ++d) {
    int c = head * 128 + vq * 32 + d;
    float y = (op[d] + o[d] * inv) * siluf_(pbv(p, row, C_BG + c));
    p.Ymix[row * 4096 + 2048 + c] = f2bf(y);
  }
}


DEVI void st_wg(const Params& p, long g) {
  int d = (int)(g & 255); long r = g >> 8;
  int rr = (int)(r & 255); r >>= 8;
  int half = (int)(r & 1); r >>= 1;
  int n = (int)(r % 10); int o = (int)(r / 10);
  int e = half * 128 + (rr & 127);
  const float* w = (rr < 128 ? p.rg_w_a : p.rg_w_i) + ((long)o * 10 + n) * 65536;
  p.Wt_g[g] = f2bf(w[d * 256 + e]);
  if (g < 2 * DR) p.SP[g] = -8.0f * softplusf_(-p.rg_lambda[g]);
  if (g < 2048) { p.LB[g] = 0.f; p.LB[2048 + g] = sigmoidf_(p.hgrn_lb_logits[2048 + g] - p.hgrn_lb_logits[g]); }
}


DEVI void st_scan1(const Params& p, long g) {
  int cp = (int)(g % 1280); int r = (int)(g / 1280);
  int ch = r & 31, b = r >> 5;
  long base = ((long)b * T_ + ch * 64) * DR + 2 * cp;
  float h0 = 0.f, h1 = 0.f, s0 = 0.f, s1 = 0.f;
#pragma unroll 16
  for (int i = 0; i < 64; ++i) {
    const unsigned la = *(const unsigned*)(p.LA + base + (long)i * DR), uu = *(const unsigned*)(p.UB + base + (long)i * DR);
    const float l0 = u_as_f(la << 16), l1 = u_as_f(la & 0xFFFF0000u);
    h0 = expf(l0) * h0 + u_as_f(uu << 16); h1 = expf(l1) * h1 + u_as_f(uu & 0xFFFF0000u);
    s0 += l0; s1 += l1;
  }
  long so = ((long)b * 32 + ch) * DR + 2 * cp;
  p.SUMP[so] = expf(s0); p.SUMP[so + 1] = expf(s1);
  p.SUMH[so] = h0; p.SUMH[so + 1] = h1;
}
DEVI void st_scan2(const Params& p, long g) {
  int cp = (int)(g % 1280); int r = (int)(g / 1280);
  int ch = r & 31, b = r >> 5;
  float h0 = 0.f, h1 = 0.f;
  for (int cc = 0; cc < ch; ++cc) {
    long so = ((long)b * 32 + cc) * DR + 2 * cp;
    h0 = p.SUMP[so] * h0 + p.SUMH[so]; h1 = p.SUMP[so + 1] * h1 + p.SUMH[so + 1];
  }
  long base = ((long)b * T_ + ch * 64) * DR + 2 * cp;
#pragma unroll 16
  for (int i = 0; i < 64; ++i) {
    const unsigned la = *(const unsigned*)(p.LA + base + (long)i * DR), uu = *(const unsigned*)(p.UB + base + (long)i * DR);
    const unsigned gs = *(const unsigned*)(p.GS + base + (long)i * DR);
    h0 = expf(u_as_f(la << 16)) * h0 + u_as_f(uu << 16); h1 = expf(u_as_f(la & 0xFFFF0000u)) * h1 + u_as_f(uu & 0xFFFF0000u);
    const float y0 = h0 * u_as_f(gs << 16), y1 = h1 * u_as_f(gs & 0xFFFF0000u);
    *(unsigned*)(p.Ymix + base + (long)i * DR) = (unsigned)f2bf(y0) | ((unsigned)f2bf(y1) << 16);
  }
}

#ifndef CPU_SHIM
#if defined(__HIP_DEVICE_COMPILE__)
typedef const __attribute__((address_space(4))) Params* KParamsPtr;
__device__ __forceinline__ KParamsPtr kparams() {
  KParamsPtr kp = (KParamsPtr)__builtin_amdgcn_kernarg_segment_ptr();
  asm volatile("" : "+s"(kp));
  return kp;
}
__device__ __forceinline__ int opaque_lane() {
  int l;
  asm volatile("v_mbcnt_lo_u32_b32 %0, -1, 0\n\tv_mbcnt_hi_u32_b32 %0, -1, %0" : "=v"(l));
  return l;
}
#define opaque_tid() (wid_s * 64 + opaque_lane())
#else
__device__ __forceinline__ const Params* kparams() { return nullptr; }
__device__ __forceinline__ int opaque_lane() { return 0; }
#define opaque_tid() (wid_s * 64 + opaque_lane())
#endif
namespace pg8 {
#define PG8_LAS __attribute__((address_space(3)))
typedef short bf16x8 __attribute__((ext_vector_type(8)));
typedef float f32x4 __attribute__((ext_vector_type(4)));
typedef unsigned u32x4 __attribute__((ext_vector_type(4)));
constexpr int BM = 256, BK = 64, HALF = 128, HTB = HALF * BK * 2  , STAGE_BYTES = 8 * HTB, NXCD = 8, WGM = 8;

__host__ __device__ __forceinline__ int lds_byte(int r, int c) { const int st = (r >> 4) * 2 + (c >> 5), rr = r & 15, cc = c & 31, ob = rr * 64 + cc * 2; return st * 1024 + (ob ^ (((ob >> 9) & 1) << 5)); }
__host__ __device__ __forceinline__ void stage_rc(int b, int& R, int& C) { const int st = b / 1024, sb = b % 1024, swz = sb ^ (((sb >> 9) & 1) << 5); R = (st >> 1) * 16 + swz / 64; C = (st & 1) * 32 + (swz % 64) / 2; }
__host__ __device__ __forceinline__ int perm32(int rho) { const int n = rho >> 4, i = rho & 15; return 8 * (i >> 2) + 4 * n + (i & 3); }

struct Unit { int pm, pn; };
struct Gemm { const bf16_t* A; const bf16_t* Bt; int M, N, K; };
struct StaticOrder {
    int nM, nN, nwg, G, c;
    __host__ __device__ void init(int M, int N, int G_, int c_) { nM = M / BM; nN = N / BM; nwg = nM * nN; G = G_; c = c_; }
    __host__ __device__ bool next(int i, Unit& u) const {
        const long L = (long)i * G + c; if (L >= nwg) return false;
        int wgid = (int)L; { const int q = nwg / NXCD, r = nwg % NXCD, xcd = wgid % NXCD, off = wgid / NXCD; wgid = (xcd < r ? xcd * (q + 1) : r * (q + 1) + (xcd - r) * q) + off; }
        const int nig = WGM * nN, gid = wgid / nig, fm = gid * WGM, gsz = (nM - fm) < WGM ? (nM - fm) : WGM;
        u.pm = fm + ((wgid % nig) % gsz); u.pn = (wgid % nig) / gsz; return true;
    }
    __device__ __forceinline__ void a_ready(const Unit&) const {}
    __device__ __forceinline__ void done(const Unit&) const {}
};
typedef float f32x2_t __attribute__((ext_vector_type(2))); typedef __bf16 bf16x2_t __attribute__((ext_vector_type(2)));
__device__ __forceinline__ unsigned cvt_pk_bf16(float lo, float hi) { f32x2_t v = {lo, hi}; bf16x2_t b = __builtin_convertvector(v, bf16x2_t); return __builtin_bit_cast(unsigned, b); }

template <class Epi, class Sched, bool ALIGN_EPI = false, bool SP2 = false>
__device__ __forceinline__ void gemm_phase(PG8_LAS unsigned char* lds, const Gemm g, const Sched& S, const Epi& E, const int wid_s) {
    const int tid = opaque_tid(), wid = wid_s, lane = tid & 63, wr = wid >> 2, wc = wid & 3, fr = lane & 15, fq = lane >> 4;
    const int K = g.K, nt = K / BK;
    unsigned voffA[2], voffB[2];
#pragma unroll
    for (int i = 0; i < 2; ++i) { int R, C; stage_rc(tid * 16 + i * 8192, R, C); const int Rb = Epi::PERM ? ((R & ~31) + perm32(R & 31)) : R;
        voffA[i] = (unsigned)(R * K + C) * 2u; voffB[i] = (unsigned)(Rb * K + C) * 2u; }
    const size_t kstep = (size_t)(BK * 2);
    const size_t hstep = (size_t)HALF * K * 2;
    const size_t tstep = 2 * hstep;
    const unsigned ldsw = (unsigned)wid * 1024u;
    const int aoff = lds_byte(wr * 64 + fr, fq * 8), boff = lds_byte(wc * 32 + fr, fq * 8);
#define PG8_SA(b, h) (((b) * 2 + (h)) * HTB)
#define PG8_SB(b, h) ((4 + (b) * 2 + (h)) * HTB)
#define PG8_STAGE(bufoff, gbase, voff) do { _Pragma("unroll") for (int _i = 0; _i < 2; ++_i) \
        __builtin_amdgcn_global_load_lds((const unsigned*)((const char*)(gbase) + (voff)[_i]), (PG8_LAS unsigned*)(lds + (bufoff) + ldsw + _i * 8192), 16, 0, 0); } while (0)
#define PG8_LDA(dst, b, h) do { _Pragma("unroll") for (int m = 0; m < 4; ++m) _Pragma("unroll") for (int k = 0; k < 2; ++k) dst[m][k] = *(const PG8_LAS bf16x8*)(lds + PG8_SA(b, h) + aoff + m * 2048 + k * 1024); } while (0)
#define PG8_LDB(dst, b, h) do { _Pragma("unroll") for (int n = 0; n < 2; ++n) _Pragma("unroll") for (int k = 0; k < 2; ++k) dst[n][k] = *(const PG8_LAS bf16x8*)(lds + PG8_SB(b, h) + boff + n * 2048 + k * 1024); } while (0)
#define PG8_MMA(ai, bj, At, Bt) do { __builtin_amdgcn_s_setprio(1); _Pragma("unroll") for (int m = 0; m < 4; ++m) _Pragma("unroll") for (int n = 0; n < 2; ++n) _Pragma("unroll") for (int k = 0; k < 2; ++k) \
        acc[ai][bj][m][n] = __builtin_amdgcn_mfma_f32_16x16x32_bf16(Bt[n][k], At[m][k], acc[ai][bj][m][n], 0, 0, 0); __builtin_amdgcn_s_setprio(0); } while (0)
#define PG8_WAIT_V(n) asm volatile("s_waitcnt vmcnt(" #n ")" ::: "memory")
#define PG8_WAIT_L(n) asm volatile("s_waitcnt lgkmcnt(" #n ")" ::: "memory")
#define PG8_BAR __builtin_amdgcn_s_barrier()
#define PG8_SCHED __builtin_amdgcn_sched_barrier(0)
    Unit cur, nxt; int ui = 0;
    if (!S.next(0, cur)) return;
    f32x4 acc[2][2][4][2];
#pragma unroll
    for (int a = 0; a < 2; ++a)
#pragma unroll
        for (int b = 0; b < 2; ++b)
#pragma unroll
            for (int m = 0; m < 4; ++m)
#pragma unroll
                for (int n = 0; n < 2; ++n) acc[a][b][m][n] = (f32x4){0.f, 0.f, 0.f, 0.f};
    bf16x8 At[4][2], B0[2][2], B1[2][2];
    const char* cA = (const char*)g.A + (size_t)cur.pm * tstep; const char* cB = (const char*)g.Bt + (size_t)cur.pn * tstep;
    S.a_ready(cur);
    if constexpr (SP2) {
        PG8_STAGE(PG8_SB(0, 0), cB, voffB); PG8_STAGE(PG8_SB(0, 1), cB + hstep, voffB); PG8_STAGE(PG8_SA(0, 0), cA, voffA); PG8_STAGE(PG8_SA(0, 1), cA + hstep, voffA);
        if (wr == 1) PG8_BAR;
        PG8_WAIT_V(2); PG8_BAR;
        PG8_STAGE(PG8_SB(1, 0), cB + kstep, voffB); PG8_STAGE(PG8_SA(1, 0), cA + kstep, voffA); PG8_STAGE(PG8_SB(1, 1), cB + hstep + kstep, voffB);
        PG8_WAIT_V(6); PG8_BAR;
    } else {
        PG8_STAGE(PG8_SB(0, 0), cB, voffB); PG8_STAGE(PG8_SA(0, 0), cA, voffA); PG8_STAGE(PG8_SB(0, 1), cB + hstep, voffB); PG8_STAGE(PG8_SA(0, 1), cA + hstep, voffA);
        if (wr == 1) PG8_BAR;
        PG8_WAIT_V(4); PG8_BAR;
        PG8_STAGE(PG8_SB(1, 0), cB + kstep, voffB); PG8_STAGE(PG8_SA(1, 0), cA + kstep, voffA); PG8_STAGE(PG8_SB(1, 1), cB + hstep + kstep, voffB);
        PG8_WAIT_V(6); PG8_BAR;
    }
    for (;;) {
        const bool has_next = S.next(ui + 1, nxt);
        const char* nA = has_next ? (const char*)g.A + (size_t)nxt.pm * tstep : cA; const char* nB = has_next ? (const char*)g.Bt + (size_t)nxt.pn * tstep : cB;
        for (int t = 0; t < nt; t += 2) {
            const bool last = (t == nt - 2);
            const char* a1 = cA + (size_t)(t + 1) * kstep;
            const char* a2 = last ? nA : cA + (size_t)(t + 2) * kstep; const char* b2 = last ? nB : cB + (size_t)(t + 2) * kstep;
            const char* a3 = a2 + kstep; const char* b3 = b2 + kstep;
            if (last && has_next) S.a_ready(nxt);
            if constexpr (SP2) {
            PG8_LDB(B0, 0, 0); PG8_LDB(B1, 0, 1); PG8_SCHED; PG8_LDA(At, 0, 0); PG8_STAGE(PG8_SA(1, 1), a1 + hstep, voffA);
            PG8_WAIT_V(8); PG8_WAIT_L(0); PG8_BAR; PG8_MMA(0, 0, At, B0); PG8_MMA(0, 1, At, B1); PG8_BAR; PG8_SCHED;
            PG8_LDA(At, 0, 1); PG8_STAGE(PG8_SB(0, 0), b2, voffB); PG8_STAGE(PG8_SB(0, 1), b2 + hstep, voffB); PG8_STAGE(PG8_SA(0, 0), a2, voffA);
            PG8_WAIT_V(8); PG8_WAIT_L(0); PG8_BAR; PG8_MMA(1, 0, At, B0); PG8_MMA(1, 1, At, B1); PG8_BAR; PG8_SCHED;
            PG8_LDB(B0, 1, 0); PG8_LDB(B1, 1, 1); PG8_SCHED; PG8_LDA(At, 1, 0); PG8_STAGE(PG8_SA(0, 1), a2 + hstep, voffA);
            PG8_WAIT_V(8); PG8_WAIT_L(0); PG8_BAR; PG8_MMA(0, 0, At, B0); PG8_MMA(0, 1, At, B1); PG8_BAR; PG8_SCHED;
            PG8_LDA(At, 1, 1); PG8_STAGE(PG8_SB(1, 0), b3, voffB); PG8_STAGE(PG8_SB(1, 1), b3 + hstep, voffB); PG8_STAGE(PG8_SA(1, 0), a3, voffA);
            PG8_WAIT_V(8); PG8_WAIT_L(0); PG8_BAR; PG8_MMA(1, 0, At, B0); PG8_MMA(1, 1, At, B1); PG8_BAR; PG8_SCHED;
            } else {
            PG8_LDB(B0, 0, 0); PG8_SCHED; PG8_LDA(At, 0, 0); PG8_STAGE(PG8_SA(1, 1), a1 + hstep, voffA);
            PG8_WAIT_L(8); PG8_BAR; PG8_WAIT_L(0); PG8_MMA(0, 0, At, B0); PG8_BAR; PG8_SCHED;
            PG8_LDB(B1, 0, 1); PG8_STAGE(PG8_SB(0, 0), b2, voffB);
            PG8_BAR; PG8_WAIT_L(0); PG8_MMA(0, 1, At, B1); PG8_BAR;
            PG8_LDA(At, 0, 1); PG8_STAGE(PG8_SA(0, 0), a2, voffA);
            PG8_BAR; PG8_WAIT_L(0); PG8_MMA(1, 0, At, B0); PG8_BAR; PG8_SCHED;
            PG8_STAGE(PG8_SB(0, 1), b2 + hstep, voffB);
            PG8_WAIT_V(6); PG8_BAR; PG8_MMA(1, 1, At, B1); PG8_BAR;
            PG8_LDB(B0, 1, 0); PG8_SCHED; PG8_LDA(At, 1, 0); PG8_STAGE(PG8_SA(0, 1), a2 + hstep, voffA);
            PG8_WAIT_L(8); PG8_BAR; PG8_WAIT_L(0); PG8_MMA(0, 0, At, B0); PG8_BAR; PG8_SCHED;
            PG8_LDB(B1, 1, 1); PG8_STAGE(PG8_SB(1, 0), b3, voffB);
            PG8_BAR; PG8_WAIT_L(0); PG8_MMA(0, 1, At, B1); PG8_BAR;
            PG8_LDA(At, 1, 1); PG8_STAGE(PG8_SA(1, 0), a3, voffA);
            PG8_BAR; PG8_WAIT_L(0); PG8_MMA(1, 0, At, B0); PG8_BAR; PG8_SCHED;
            PG8_STAGE(PG8_SB(1, 1), b3 + hstep, voffB);
            PG8_WAIT_V(6); PG8_BAR; PG8_MMA(1, 1, At, B1); PG8_BAR;
            }
        }
        if constexpr (ALIGN_EPI) { if (wr == 0) PG8_BAR; }
        if constexpr (!Epi::AFTER_DRAIN) { E(acc, cur, wr, wc, fr, fq); S.done(cur); }
        if (!has_next) break;
#pragma unroll
        for (int a = 0; a < 2; ++a)
#pragma unroll
            for (int b = 0; b < 2; ++b)
#pragma unroll
                for (int m = 0; m < 4; ++m)
#pragma unroll
                    for (int n = 0; n < 2; ++n) acc[a][b][m][n] = (f32x4){0.f, 0.f, 0.f, 0.f};
        cur = nxt; cA = nA; cB = nB; ++ui;
        if constexpr (ALIGN_EPI) { if (wr == 1) PG8_BAR; }
    }
    PG8_WAIT_V(0);
    if constexpr (!ALIGN_EPI) { if (wr == 0) PG8_BAR; }
    PG8_BAR;
    if constexpr (Epi::AFTER_DRAIN) { E.fused(acc, cur, wr, wc, fr, fq, lds, wid, lane); S.done(cur); }
#undef PG8_SA
#undef PG8_SB
#undef PG8_STAGE
#undef PG8_LDA
#undef PG8_LDB
#undef PG8_MMA
#undef PG8_WAIT_V
#undef PG8_WAIT_L
#undef PG8_BAR
#undef PG8_SCHED
}
}

#define LAS __attribute__((address_space(3)))
using pg8::f32x4;
using pg8::bf16x8;

struct EpiStoreF32 {
  static constexpr bool PERM = false, AFTER_DRAIN = false;
  float* C; int ldc;
  __device__ __forceinline__ void operator()(const f32x4 (&acc)[2][2][4][2], const pg8::Unit& u, int wr, int wc, int fr, int fq) const {
    const int row0 = u.pm * 256 + wr * 64 + fr, col0 = u.pn * 256 + wc * 32 + 4 * fq;
#pragma unroll
    for (int ai = 0; ai < 2; ++ai)
#pragma unroll
      for (int m = 0; m < 4; ++m) {
        float* rowp = C + (size_t)(row0 + ai * 128 + m * 16) * ldc + col0;
#pragma unroll
        for (int bj = 0; bj < 2; ++bj)
#pragma unroll
          for (int n = 0; n < 2; ++n) *(f32x4*)(rowp + bj * 128 + n * 16) = acc[ai][bj][m][n];
      }
  }
};
struct EpiAccumF32 {
  static constexpr bool PERM = false, AFTER_DRAIN = false;
  float* C; int ldc; const float* S;
  __device__ __forceinline__ void operator()(const f32x4 (&acc)[2][2][4][2], const pg8::Unit& u, int wr, int wc, int fr, int fq) const {
    const int row0 = u.pm * 256 + wr * 64 + fr, col0 = u.pn * 256 + wc * 32 + 4 * fq;
#pragma unroll
    for (int ai = 0; ai < 2; ++ai) {
      f32x4 cv[4][2][2];
#pragma unroll
      for (int m = 0; m < 4; ++m) {
        const float* rowp = S + (size_t)(row0 + ai * 128 + m * 16) * ldc + col0;
#pragma unroll
        for (int bj = 0; bj < 2; ++bj)
#pragma unroll
          for (int n = 0; n < 2; ++n) cv[m][bj][n] = *(const f32x4*)(rowp + bj * 128 + n * 16);
      }
#pragma unroll
      for (int m = 0; m < 4; ++m) {
        float* rowp = C + (size_t)(row0 + ai * 128 + m * 16) * ldc + col0;
#pragma unroll
        for (int bj = 0; bj < 2; ++bj)
#pragma unroll
          for (int n = 0; n < 2; ++n) *(f32x4*)(rowp + bj * 128 + n * 16) = cv[m][bj][n] + acc[ai][bj][m][n];
      }
    }
  }
};
__device__ __forceinline__ float fexp_(float x) { return __builtin_amdgcn_exp2f(x * 1.4426950408889634f); }
__device__ __forceinline__ float fsigmoid_(float x) { return __builtin_amdgcn_rcpf(1.0f + fexp_(-x)); }
__device__ __forceinline__ float fsilu_(float x) { return x * fsigmoid_(x); }
__device__ __forceinline__ float one_minus_exp_(float x) {
  const float big = 1.0f - fexp_(x);
  const float small = -x * (1.0f + x * (0.5f + x * (0.16666667f + x * 0.041666668f)));
  return x > -0.125f ? small : big;
}


struct EpiEvenIn {
  static constexpr bool PERM = false, AFTER_DRAIN = false;
  bf16_t* QS; float* LF; bf16_t* KK; bf16_t* AVT; const float* LB; bf16_t* PB; bf16_t* VT; bf16_t* KVC;
  __device__ __forceinline__ void operator()(const f32x4 (&acc)[2][2][4][2], const pg8::Unit& u, int wr, int wc, int fr, int fq) const {
    const int row0 = u.pm * 256 + wr * 64 + fr, col0 = u.pn * 256 + wc * 32 + 4 * fq;
    const int pn = u.pn;
    f32x4 lbv[2][2];
    if (pn >= 8 && pn < 16) {
#pragma unroll
      for (int bj = 0; bj < 2; ++bj)
#pragma unroll
        for (int n = 0; n < 2; ++n) lbv[bj][n] = *(const f32x4*)(LB + (col0 + bj * 128 + n * 16 - 2048));
#pragma unroll
      for (int bj = 0; bj < 2; ++bj)
#pragma unroll
        for (int n = 0; n < 2; ++n) asm volatile("" : "+v"(lbv[bj][n]));
    }
#pragma unroll
    for (int ai = 0; ai < 2; ++ai)
#pragma unroll
      for (int m = 0; m < 4; ++m) {
        const long row = row0 + ai * 128 + m * 16;
#pragma unroll
        for (int bj = 0; bj < 2; ++bj)
#pragma unroll
          for (int n = 0; n < 2; ++n) {
            const f32x4 v = acc[ai][bj][m][n];
            const int col = col0 + bj * 128 + n * 16;
            if (pn < 8) {
              uint2 w; w.x = pg8::cvt_pk_bf16(fsilu_(v[0]), fsilu_(v[1])); w.y = pg8::cvt_pk_bf16(fsilu_(v[2]), fsilu_(v[3]));
              *(uint2*)(QS + row * 2048 + col) = w;
            } else if (pn < 16) {
              const int c = col - 2048;
              const f32x4 lb = lbv[bj][n];
              f32x4 lf; float kk[4];
#pragma unroll
              for (int i = 0; i < 4; ++i) {
                const float sg = fsigmoid_(v[i]);
                const float f = lb[i] + (1.0f - lb[i]) * sg;
                lf[i] = __builtin_amdgcn_logf(fmaxf(f, 1e-30f)) * 0.6931471805599453f;
                kk[i] = (1.0f - lb[i]) * fsigmoid_(-v[i]);
              }
              *(f32x4*)(LF + row * 2048 + c) = lf;
              uint2 w; w.x = pg8::cvt_pk_bf16(kk[0], kk[1]); w.y = pg8::cvt_pk_bf16(kk[2], kk[3]);
              *(uint2*)(KK + row * 2048 + c) = w;
            } else if (pn < 24) {
              const int c = col - 4096;
              const long bb = row >> 11; const int t = (int)(row & 2047);
              bf16_t* dst = AVT + ((bb * 2048) + c) * T_ + t;
#pragma unroll
              for (int i = 0; i < 4; ++i) dst[(long)i * T_] = f2bf(v[i]);
            } else if (pn == 46 || pn == 47 || pn == 50 || pn == 51) {
              const int which = pn >= 50;
              const int c = col - (which ? C_VW : C_VS);
              const long bb = row >> 11; const int t = (int)(row & 2047);
              bf16_t* dst = VT + (((long)which * NB + bb) * 512 + c) * T_ + t;
#pragma unroll
              for (int i = 0; i < 4; ++i) dst[(long)i * T_] = f2bf(v[i]);
            } else if (pn >= 40 && pn < 44) {
              const int kv = pn >= 42;
              const int c = col - (kv ? C_VC : C_KC);
              const long bb = row >> 11; const int t = (int)(row & 2047);
              uint2 w; w.x = pg8::cvt_pk_bf16(v[0], v[1]); w.y = pg8::cvt_pk_bf16(v[2], v[3]);
              *(uint2*)(KVC + ((((long)kv * NB + bb) * 4 + (c >> 7)) * T_ + t) * 128 + (c & 127)) = w;
            } else {
              uint2 w; w.x = pg8::cvt_pk_bf16(v[0], v[1]); w.y = pg8::cvt_pk_bf16(v[2], v[3]);
              *(uint2*)(PB + row * PB_W + (col - PA_W)) = w;
            }
          }
      }
  }
};

struct DiagOrder {
  int G, c;
  __device__ bool next(int i, pg8::Unit& u) const {
    const int L = i * G + c; if (L >= 640) return false;
    const int n = L >> 6, rem = L & 63;
    u.pm = n * 32 + (rem & 31); u.pn = n * 2 + (rem >> 5); return true;
  }
  __device__ __forceinline__ void a_ready(const pg8::Unit&) const {}
  __device__ __forceinline__ void done(const pg8::Unit&) const {}
};
struct CmpOrder {
  int G, c;
  __device__ bool next(int i, pg8::Unit& u) const {
    const int L = i * G + c; if (L >= 16) return false;
    u.pm = L; u.pn = L >> 3; return true;
  }
  __device__ __forceinline__ void a_ready(const pg8::Unit&) const {}
  __device__ __forceinline__ void done(const pg8::Unit&) const {}
};
struct EpiZ {
  static constexpr bool PERM = false, AFTER_DRAIN = false;
  float* C;
  __device__ __forceinline__ void operator()(const f32x4 (&acc)[2][2][4][2], const pg8::Unit& u, int wr, int wc, int fr, int fq) const {
    const int row0 = u.pm * 256 + wr * 64 + fr, col0 = wc * 32 + 4 * fq;
#pragma unroll
    for (int ai = 0; ai < 2; ++ai)
#pragma unroll
      for (int m = 0; m < 4; ++m) {
        float* rowp = C + (size_t)(row0 + ai * 128 + m * 16) * 256 + col0;
#pragma unroll
        for (int bj = 0; bj < 2; ++bj)
#pragma unroll
          for (int n = 0; n < 2; ++n) *(f32x4*)(rowp + bj * 128 + n * 16) = acc[ai][bj][m][n];
      }
  }
};
struct EpiGates {
  static constexpr bool PERM = false, AFTER_DRAIN = false;
  const bf16_t* XCb; const float* b_a; const float* b_i; const float* lam; bf16_t* LA; bf16_t* UB;
  __device__ __forceinline__ void operator()(const f32x4 (&acc)[2][2][4][2], const pg8::Unit& u, int wr, int wc, int fr, int fq) const {
    const int n = u.pn >> 1, half = u.pn & 1;
    const int row0 = (u.pm & 31) * 256 + wr * 64 + fr;
    const int el0 = 128 * half + 32 * wc + 4 * fq;
    f32x4 bav[2], biv[2], spv[2]; uint2 xwv[2][2][4];
#pragma unroll
    for (int nn = 0; nn < 2; ++nn) {
      const int el = el0 + 16 * nn, c = n * 256 + el;
      bav[nn] = *(const f32x4*)(b_a + c); biv[nn] = *(const f32x4*)(b_i + c); spv[nn] = *(const f32x4*)(lam + c);
#pragma unroll
      for (int ai = 0; ai < 2; ++ai)
#pragma unroll
        for (int m = 0; m < 4; ++m) xwv[nn][ai][m] = *(const uint2*)(XCb + ((long)n * M_ + (row0 + ai * 128 + m * 16)) * 256 + el);
    }
#pragma unroll
    for (int nn = 0; nn < 2; ++nn) {
      asm volatile("" : "+v"(bav[nn])); asm volatile("" : "+v"(biv[nn])); asm volatile("" : "+v"(spv[nn]));
#pragma unroll
      for (int ai = 0; ai < 2; ++ai)
#pragma unroll
        for (int m = 0; m < 4; ++m) asm volatile("" : "+v"(xwv[nn][ai][m]));
    }
#pragma unroll
    for (int nn = 0; nn < 2; ++nn) {
      const int el = el0 + 16 * nn, c = n * 256 + el;
      const f32x4 ba = bav[nn], bi = biv[nn], sp = spv[nn];
#pragma unroll
      for (int ai = 0; ai < 2; ++ai)
#pragma unroll
        for (int m = 0; m < 4; ++m) {
          const long row = row0 + ai * 128 + m * 16;
          const uint2 xw = xwv[nn][ai][m];
          const float xc[4] = {u_as_f(xw.x << 16), u_as_f(xw.x & 0xFFFF0000u), u_as_f(xw.y << 16), u_as_f(xw.y & 0xFFFF0000u)};
          float la[4], uv[4];
#pragma unroll
          for (int i = 0; i < 4; ++i) {
            const float r = fsigmoid_(acc[ai][0][m][nn][i] + ba[i]);
            const float ig = fsigmoid_(acc[ai][1][m][nn][i] + bi[i]);
            la[i] = sp[i] * r;
            uv[i] = __builtin_amdgcn_sqrtf(fmaxf(one_minus_exp_(2.0f * la[i]), 0.f)) * (ig * xc[i]);
          }
          uint2 wl, wu;
          wl.x = pg8::cvt_pk_bf16(la[0], la[1]); wl.y = pg8::cvt_pk_bf16(la[2], la[3]);
          wu.x = pg8::cvt_pk_bf16(uv[0], uv[1]); wu.y = pg8::cvt_pk_bf16(uv[2], uv[3]);
          *(uint2*)(LA + row * DR + c) = wl;
          *(uint2*)(UB + row * DR + c) = wu;
        }
    }
  }
};
struct EpiOddIn {
  static constexpr bool PERM = false, AFTER_DRAIN = false;
  bf16_t* XB; bf16_t* GS;
  __device__ __forceinline__ void operator()(const f32x4 (&acc)[2][2][4][2], const pg8::Unit& u, int wr, int wc, int fr, int fq) const {
    const int row0 = u.pm * 256 + wr * 64 + fr, col0 = u.pn * 256 + wc * 32 + 4 * fq;
    const bool gate = u.pn >= 10;
    bf16_t* dst = gate ? GS - DR : XB;
#pragma unroll
    for (int ai = 0; ai < 2; ++ai)
#pragma unroll
      for (int m = 0; m < 4; ++m) {
        bf16_t* rowp = dst + (size_t)(row0 + ai * 128 + m * 16) * DR + col0;
#pragma unroll
        for (int bj = 0; bj < 2; ++bj)
#pragma unroll
          for (int n = 0; n < 2; ++n) {
            f32x4 v = acc[ai][bj][m][n];
            if (gate) { v[0] = fsilu_(v[0]); v[1] = fsilu_(v[1]); v[2] = fsilu_(v[2]); v[3] = fsilu_(v[3]); }
            uint2 w; w.x = pg8::cvt_pk_bf16(v[0], v[1]); w.y = pg8::cvt_pk_bf16(v[2], v[3]);
            *(uint2*)(rowp + bj * 128 + n * 16) = w;
          }
      }
  }
};

__device__ void wt_convert(const float* __restrict__ W, bf16_t* __restrict__ Wt, int K, int N, int Npad, float* tile  , int bid, int nblk, int tid) {
  const int tk = K / 64, tn = Npad / 64;
  for (int t = bid; t < tk * tn; t += nblk) {
    const int k0 = (t % tk) * 64, n0 = (t / tk) * 64;
    {
      const int r = tid >> 4, c4 = (tid & 15) * 4;
#pragma unroll
      for (int i = 0; i < 2; ++i) {
        const int rr = r + 32 * i;
        float4 v = make_float4(0.f, 0.f, 0.f, 0.f);
        if (n0 + c4 < N) v = *(const float4*)(W + (size_t)(k0 + rr) * N + n0 + c4);
        tile[rr * 65 + c4 + 0] = v.x; tile[rr * 65 + c4 + 1] = v.y; tile[rr * 65 + c4 + 2] = v.z; tile[rr * 65 + c4 + 3] = v.w;
      }
    }
    __syncthreads();
    {
      const int n = tid >> 3, kq = (tid & 7) * 8;
      unsigned w[4];
#pragma unroll
      for (int j = 0; j < 4; ++j)
        w[j] = (unsigned)f2bf(tile[(kq + 2 * j) * 65 + n]) | ((unsigned)f2bf(tile[(kq + 2 * j + 1) * 65 + n]) << 16);
      *(uint4*)(Wt + (size_t)(n0 + n) * K + k0 + kq) = make_uint4(w[0], w[1], w[2], w[3]);
    }
    __syncthreads();
  }
}

__device__ void wt_convert256(const float* __restrict__ W, bf16_t* __restrict__ Wt, int K, int N, int Npad, float* tile  , int bid, int nblk, int tid) {
  const int tk = K / 64, tn = Npad / 256, nt = tk * tn;
  const int r = tid >> 6, c4 = (tid & 63) * 4;
  f32x4 v[8];
#define WT_LOAD(t_) do { const int k0_ = ((t_) % tk) * 64, n0_ = ((t_) / tk) * 256; const bool in_ = n0_ + c4 < N; const int cc_ = in_ ? n0_ + c4 : 0; \
    _Pragma("unroll") for (int i = 0; i < 8; ++i) { v[i] = *(const f32x4*)(W + (size_t)(k0_ + r + 8 * i) * N + cc_); \
      if (!in_) v[i] = (f32x4){0.f, 0.f, 0.f, 0.f}; } } while (0)
  int t = bid;
  if (t < nt) WT_LOAD(t);
  for (; t < nt; t += nblk) {
    const int k0 = (t % tk) * 64, n0 = (t / tk) * 256;
#pragma unroll
    for (int i = 0; i < 8; ++i) {
      float* d = tile + (r + 8 * i) * 257 + c4;
      d[0] = v[i][0]; d[1] = v[i][1]; d[2] = v[i][2]; d[3] = v[i][3];
    }
    if (t + nblk < nt) WT_LOAD(t + nblk);
    __syncthreads();
#pragma unroll
    for (int i = 0; i < 4; ++i) {
      const int c = tid + 512 * i, n = c >> 3, kq = (c & 7) * 8;
      unsigned w[4];
#pragma unroll
      for (int j = 0; j < 4; ++j)
        w[j] = (unsigned)f2bf(tile[(kq + 2 * j) * 257 + n]) | ((unsigned)f2bf(tile[(kq + 2 * j + 1) * 257 + n]) << 16);
      *(uint4*)(Wt + (size_t)(n0 + n) * K + k0 + kq) = make_uint4(w[0], w[1], w[2], w[3]);
    }
    __syncthreads();
  }
#undef WT_LOAD
}
#endif

enum StageKind {
  SK_WT, SK_COPY, SK_ROWSS, SK_NORM, SK_GEMM_EIN, SK_HGRN_PREP, SK_HGRN_REC, SK_HGRN_POST, SK_CMP_HID, SK_CMP_OUT,
  SK_CMP_ATTN, SK_IMP, SK_TOPK, SK_SEL_ATTN, SK_WIN_ATTN, SK_GEMM_EOUT, SK_GEMM_OIN, SK_CONV, SK_GATES,
  SK_SCAN, SK_GEMM_OOUT, SK_FINAL, SK_VT, SK_CONVB, SK_WG, SK_SCAN1, SK_SCAN2, SK_CMP_HID2, SK_CMP_HIDOUT
};
constexpr int N_STAGES = 2 + 2 * 14 + 2 * 7 + 2;

DEVI int even_kind(int i) {
  switch (i) {
    case 0: return SK_ROWSS; case 1: return SK_NORM; case 2: return SK_GEMM_EIN; case 3: return SK_HGRN_PREP;
    case 4: return SK_HGRN_REC; case 5: return SK_HGRN_POST; case 6: return SK_CMP_HID; case 7: return SK_CMP_OUT;
    case 8: return SK_CMP_ATTN; case 9: return SK_IMP; case 10: return SK_TOPK; case 11: return SK_SEL_ATTN;
    case 12: return SK_WIN_ATTN; default: return SK_GEMM_EOUT;
  }
}
DEVI int odd_kind(int i) {
  switch (i) {
    case 0: return SK_ROWSS; case 1: return SK_NORM; case 2: return SK_GEMM_OIN; case 3: return SK_CONV;
    case 4: return SK_GATES; case 5: return SK_SCAN; default: return SK_GEMM_OOUT;
  }
}
DEVI void stage_desc(int s, int& kind, int& layer) {
  if (s == 0) { kind = SK_WT; layer = 0; return; }
  if (s == 1) { kind = SK_COPY; layer = 0; return; }
  s -= 2;
  for (int l = 0; l < 4; ++l) {
    int n = (l & 1) ? 7 : 14;
    if (s < n) {
      layer = l;
      kind = (l & 1) ? odd_kind(s) : even_kind(s);
      return;
    }
    s -= n;
  }
  layer = 4;
  kind = s == 0 ? SK_ROWSS : SK_FINAL;
}

DEVI long stage_threads(int kind) {
  switch (kind) {
    case SK_WT: return N_WT;
    case SK_COPY: return (long)M_ * D_;
    case SK_ROWSS: return (long)M_ * 16;
    case SK_NORM: return (long)M_ * D_;
    case SK_HGRN_PREP: return (long)M_ * 2048;
    case SK_HGRN_REC: return (long)NB * 16 * 128;
    case SK_HGRN_POST: return (long)M_ * 16;
    case SK_CMP_HID: return 2L * NB * 4 * NCMP * 128;
    case SK_CMP_OUT: return 2L * NB * 4 * NCMP * 128;
    case SK_CMP_HID2: return 2L * NB * 4 * NCMP * 128;
    case SK_CMP_HIDOUT: return 2L * NB * 4 * NCMP * 128;
    case SK_CMP_ATTN: return (long)NB * 16 * T_;
    case SK_IMP: return (long)M_ * 4 * 32;
    case SK_TOPK: return (long)M_ * 4;
    case SK_SEL_ATTN: return (long)NB * 16 * T_ * 4;
    case SK_WIN_ATTN: return (long)NB * 16 * T_ * 4;
    case SK_CONV: return (long)M_ * DR;
    case SK_GATES: return (long)M_ * DR;
    case SK_SCAN: return (long)NB * DR;
    case SK_FINAL: return (long)M_ * D_;
    case SK_VT: return 2L * NB * 4 * 128 * T_;
    case SK_CONVB: return (long)M_ * DR;
    case SK_WG: return 2L * 10 * 2 * 256 * 256;
    case SK_SCAN1: return (long)NB * 32 * 1280;
    case SK_SCAN2: return (long)NB * 32 * 1280;
    default: return 0;
  }
}

DEVI void stage_thread(const Params& p, int kind, int layer, long g) {
  const int e = layer >> 1;
  switch (kind) {
    case SK_WT: st_wt(p, g); break;
    case SK_COPY: st_copy(p, g); break;
    case SK_ROWSS: st_rowss(p, g); break;
    case SK_NORM: st_norm(p, layer, g); break;
    case SK_HGRN_POST: st_hgrn_post(p, e, g); break;
    case SK_HGRN_REC: st_hgrn_rec2(p, g); break;
    case SK_CMP_HID: st_cmp_hid(p, e, g); break;
    case SK_CMP_OUT: st_cmp_out(p, e, g); break;
    case SK_CMP_HID2: st_cmp_hid2(p, e, g); break;
    case SK_CMP_HIDOUT: st_cmp_hidout(p, e, g); break;
    case SK_CMP_ATTN: st_cmp_attn(p, g); break;
    case SK_IMP: st_imp(p, g); break;
    case SK_TOPK: st_topk(p, g); break;
    case SK_SEL_ATTN: st_sel_attn(p, g); break;
    case SK_WIN_ATTN: st_win_attn(p, g); break;
    case SK_FINAL: st_final(p, g); break;
    case SK_WG: st_wg(p, g); break;
    case SK_SCAN1: st_scan1(p, g); break;
    case SK_SCAN2: st_scan2(p, g); break;
    default: break;
  }
}

#ifndef CPU_SHIM
#ifndef SP2_EIN
#define SP2_EIN true
#endif
#ifndef SP2_OUT
#define SP2_OUT true
#endif
#ifndef SP2_OIN
#define SP2_OIN true
#endif
#ifndef SP2_GATES
#define SP2_GATES false
#endif
#ifndef SP2_CMP
#define SP2_CMP true
#endif
constexpr bool GEMM_ALIGN = true;
constexpr int NTHREADS = 512;
constexpr int NBLK = 256;

using f32x16 = __attribute__((ext_vector_type(16))) float;
using u32x4v = __attribute__((ext_vector_type(4))) unsigned int;
using u32x2v = __attribute__((ext_vector_type(2))) unsigned int;
constexpr int AT_OSTR = 528;
constexpr int AT_KSTR = 272, AT_VSTR = 136, AT_KBYTES = 64 * AT_KSTR, AT_VBYTES = 128 * AT_VSTR, AT_BUF = AT_KBYTES + AT_VBYTES;
constexpr float LOG2E_F = 1.4426950408889634f;

__device__ __forceinline__ bf16x8 scale_bf16x8(bf16x8 v, float sc) {
  u32x4v w = __builtin_bit_cast(u32x4v, v);
  u32x4v o;
#pragma unroll
  for (int i = 0; i < 4; ++i) {
    float lo = u_as_f(w[i] << 16) * sc, hi = u_as_f(w[i] & 0xFFFF0000u) * sc;
    o[i] = pg8::cvt_pk_bf16(lo, hi);
  }
  return __builtin_bit_cast(bf16x8, o);
}
__device__ __forceinline__ float xhalf_max(const float v) {
  auto rr = __builtin_amdgcn_permlane32_swap(__float_as_uint(v), __float_as_uint(v), false, false);
  return fmaxf(__uint_as_float(rr[0]), __uint_as_float(rr[1]));
}
__device__ __forceinline__ float xhalf_sum(const float v) {
  auto rr = __builtin_amdgcn_permlane32_swap(__float_as_uint(v), __float_as_uint(v), false, false);
  return __uint_as_float(rr[0]) + __uint_as_float(rr[1]);
}
__device__ __forceinline__ bf16x8 pack_bf16x8(const f32x16& pv, int base) {
  u32x4v o;
#pragma unroll
  for (int i = 0; i < 4; ++i) o[i] = pg8::cvt_pk_bf16(pv[base + 2 * i], pv[base + 2 * i + 1]);
  return __builtin_bit_cast(bf16x8, o);
}


constexpr int HG_TOT = 0, HG_E1 = 2048, HG_E2 = 2560, HG_QT = 3072, HG_KT = HG_QT + 17408, HG_KTT = HG_KT + 17408,
              HG_VTT = HG_KTT + 18432, HG_SPT = HG_VTT + 4608;

__device__ __forceinline__ void hgrn_phase(const Params& p, LAS unsigned char* lds, const int tid, const int wid) {
  const int lane = tid & 63, l31 = lane & 31, hi = lane >> 5;
  const int item = blockIdx.x;
  const int vs = item & 3, h = (item >> 2) & 15, b = item >> 6;
  const int k = tid & 127, rq = tid >> 7;
  LAS float* TOT = (LAS float*)(lds + HG_TOT);
  LAS float* E1 = (LAS float*)(lds + HG_E1);
  LAS float* E2 = (LAS float*)(lds + HG_E2);
  f32x16 S;
#pragma unroll
  for (int r = 0; r < 16; ++r) S[r] = 0.f;
  float lf[16]; unsigned short qs[16], kk[16]; u32x4v vreg;
  const float* LFp = p.LF + ((long)b * T_ + 16 * rq) * 2048 + h * 128 + k;
  const bf16_t* QSp = p.QS + ((long)b * T_ + 16 * rq) * 2048 + h * 128 + k;
  const bf16_t* KKp = p.KK + ((long)b * T_ + 16 * rq) * 2048 + h * 128 + k;
  const bf16_t* AVp = p.AVT + (((long)b * 16 + h) * 128 + 32 * vs + ((tid >> 3) & 31)) * T_ + (tid & 7) * 8;
#pragma unroll
  for (int i = 0; i < 16; ++i) { lf[i] = LFp[(long)i * 2048]; qs[i] = QSp[(long)i * 2048]; kk[i] = KKp[(long)i * 2048]; }
  vreg = *(const u32x4v*)(AVp);
  for (int c = 0; c < 32; ++c) {
    float cs[16];
    cs[0] = lf[0];
#pragma unroll
    for (int i = 1; i < 16; ++i) cs[i] = cs[i - 1] + lf[i];
    TOT[rq * 128 + k] = cs[15];
    __syncthreads();
    {
      const float t0 = TOT[k], t1 = TOT[128 + k], t2 = TOT[256 + k], t3 = TOT[384 + k];
      const float off = (rq > 0 ? t0 : 0.f) + (rq > 1 ? t1 : 0.f) + (rq > 2 ? t2 : 0.f);
      const float R = t0 + t1, GL = (t0 + t1) + (t2 + t3);
      if (rq == 0) { E1[k] = fexp_(GL); E2[k] = fexp_(GL - R); }
      unsigned kt[8];
#pragma unroll
      for (int i = 0; i < 16; i += 2) {
        const float G0 = off + cs[i], G1 = off + cs[i + 1];
        const float q0 = u_as_f((unsigned)qs[i] << 16) * fexp_(G0 - R), q1 = u_as_f((unsigned)qs[i + 1] << 16) * fexp_(G1 - R);
        const float k0 = u_as_f((unsigned)kk[i] << 16) * fexp_(R - G0), k1 = u_as_f((unsigned)kk[i + 1] << 16) * fexp_(R - G1);
        const unsigned qp = pg8::cvt_pk_bf16(q0, q1), kp = pg8::cvt_pk_bf16(k0, k1);
        *(LAS unsigned short*)(lds + HG_QT + (16 * rq + i) * 272 + k * 2) = (unsigned short)(qp & 0xFFFFu);
        *(LAS unsigned short*)(lds + HG_QT + (16 * rq + i + 1) * 272 + k * 2) = (unsigned short)(qp >> 16);
        *(LAS unsigned short*)(lds + HG_KT + (16 * rq + i) * 272 + k * 2) = (unsigned short)(kp & 0xFFFFu);
        *(LAS unsigned short*)(lds + HG_KT + (16 * rq + i + 1) * 272 + k * 2) = (unsigned short)(kp >> 16);
        kt[i >> 1] = kp;
      }
      *(LAS u32x4v*)(lds + HG_KTT + k * 144 + rq * 32) = (u32x4v){kt[0], kt[1], kt[2], kt[3]};
      *(LAS u32x4v*)(lds + HG_KTT + k * 144 + rq * 32 + 16) = (u32x4v){kt[4], kt[5], kt[6], kt[7]};
      if (tid < 256) *(LAS u32x4v*)(lds + HG_VTT + (tid >> 3) * 144 + (tid & 7) * 16) = vreg;
      if (wid < 4) {
#pragma unroll
        for (int r4 = 0; r4 < 4; ++r4) {
          const int kb = 32 * wid + 8 * r4 + 4 * hi;
          const f32x4 ra = *(const LAS f32x4*)(lds + HG_TOT + kb * 4), rb = *(const LAS f32x4*)(lds + HG_TOT + 512 + kb * 4);
          u32x2v w;
          w[0] = pg8::cvt_pk_bf16(S[4 * r4 + 0] * fexp_(ra[0] + rb[0]), S[4 * r4 + 1] * fexp_(ra[1] + rb[1]));
          w[1] = pg8::cvt_pk_bf16(S[4 * r4 + 2] * fexp_(ra[2] + rb[2]), S[4 * r4 + 3] * fexp_(ra[3] + rb[3]));
          *(LAS u32x2v*)(lds + HG_SPT + l31 * 272 + kb * 2) = w;
        }
      }
    }
    __syncthreads();
    if (c + 1 < 32) {
      const long adv = (long)(c + 1) * 64 * 2048;
#pragma unroll
      for (int i = 0; i < 16; ++i) { lf[i] = LFp[adv + (long)i * 2048]; qs[i] = QSp[adv + (long)i * 2048]; kk[i] = KKp[adv + (long)i * 2048]; }
      vreg = *(const u32x4v*)(AVp + (c + 1) * 64);
    }
    if (wid < 4) {
      f32x16 W;
#pragma unroll
      for (int r = 0; r < 16; ++r) W[r] = 0.f;
#pragma unroll
      for (int ss = 0; ss < 4; ++ss) {
        const bf16x8 a = *(const LAS bf16x8*)(lds + HG_KTT + (32 * wid + l31) * 144 + ss * 32 + hi * 16);
        const bf16x8 bb = *(const LAS bf16x8*)(lds + HG_VTT + l31 * 144 + ss * 32 + hi * 16);
        W = __builtin_amdgcn_mfma_f32_32x32x16_bf16(a, bb, W, 0, 0, 0);
      }
#pragma unroll
      for (int r4 = 0; r4 < 4; ++r4) {
        const int kb = 32 * wid + 8 * r4 + 4 * hi;
        const f32x4 e1 = *(const LAS f32x4*)(lds + HG_E1 + kb * 4), e2 = *(const LAS f32x4*)(lds + HG_E2 + kb * 4);
#pragma unroll
        for (int i = 0; i < 4; ++i) S[4 * r4 + i] = e1[i] * S[4 * r4 + i] + e2[i] * W[4 * r4 + i];
      }
    } else if (wid < 6) {
      const int th = wid - 4;
      f32x16 O;
#pragma unroll
      for (int r = 0; r < 16; ++r) O[r] = 0.f;
#pragma unroll
      for (int ks = 0; ks < 8; ++ks) {
        const bf16x8 a = *(const LAS bf16x8*)(lds + HG_QT + (32 * th + l31) * 272 + ks * 32 + hi * 16);
        const bf16x8 bb = *(const LAS bf16x8*)(lds + HG_SPT + l31 * 272 + ks * 32 + hi * 16);
        O = __builtin_amdgcn_mfma_f32_32x32x16_bf16(a, bb, O, 0, 0, 0);
      }
      for (int sh = 0; sh <= th; ++sh) {
        f32x16 X;
#pragma unroll
        for (int r = 0; r < 16; ++r) X[r] = 0.f;
#pragma unroll
        for (int ks = 0; ks < 8; ++ks) {
          const bf16x8 a = *(const LAS bf16x8*)(lds + HG_KT + (32 * sh + l31) * 272 + ks * 32 + hi * 16);
          const bf16x8 bb = *(const LAS bf16x8*)(lds + HG_QT + (32 * th + l31) * 272 + ks * 32 + hi * 16);
          X = __builtin_amdgcn_mfma_f32_32x32x16_bf16(a, bb, X, 0, 0, 0);
        }
        if (sh == th) {
#pragma unroll
          for (int r = 0; r < 16; ++r) if ((r & 3) + 8 * (r >> 2) + 4 * hi > l31) X[r] = 0.f;
        }
#pragma unroll
        for (int s2 = 0; s2 < 2; ++s2) {
          const bf16x8 ap = pack_bf16x8(X, 8 * s2);
          LAS unsigned char* vp = lds + HG_VTT + l31 * 144 + (32 * sh + 16 * s2 + 4 * hi) * 2;
          const u32x2v v0 = *(const LAS u32x2v*)(vp), v1 = *(const LAS u32x2v*)(vp + 16);
          const u32x4v vv = {v0[0], v0[1], v1[0], v1[1]};
          O = __builtin_amdgcn_mfma_f32_32x32x16_bf16(ap, __builtin_bit_cast(bf16x8, vv), O, 0, 0, 0);
        }
      }
      float* op = p.OA + ((long)b * T_ + c * 64 + 32 * th) * 2048 + h * 128 + 32 * vs + l31;
#pragma unroll
      for (int r = 0; r < 16; ++r) op[(long)((r & 3) + 8 * (r >> 2) + 4 * hi) * 2048] = O[r];
    }
  }
  __syncthreads();
}


constexpr int CP_K = 0, CP_V = 34816, CP_IMP = 69632, CP_SC = CP_IMP + 32768;

__device__ __forceinline__ void cmp_phase(const Params& p, LAS unsigned char* lds, const int tid, const int wid, const int first, const int step) {
  const int lane = tid & 63, l31 = lane & 31, hi = lane >> 5;
  const int hh = wid >> 1, th = wid & 1;
  const float NEG_INF_F = -__builtin_inff();
  for (int it = first; it < 512; it += step) {
    {
      const int qt = 31 - (it >> 4), bg = it & 15, b = bg >> 2, g = bg & 3;
      const int nkt = (qt >> 3) + 1;
      {
        const bf16_t* kc = p.KCb + (long)bg * 128 * 128;
        const bf16_t* vt = p.VCT + (long)bg * 128 * 128;
#pragma unroll
        for (int i = 0; i < 4; ++i) {
          const int c = tid + i * 512;
          const u32x4v kv_ = *(const u32x4v*)(kc + (c >> 4) * 128 + (c & 15) * 8);
          const u32x4v vv_ = *(const u32x4v*)(vt + (c >> 4) * 128 + (c & 15) * 8);
          *(LAS u32x4v*)(lds + CP_K + (c >> 4) * 272 + (c & 15) * 16) = kv_;
          *(LAS u32x4v*)(lds + CP_V + (c >> 4) * 272 + (c & 15) * 16) = vv_;
        }
      }
      const int head = g * 4 + hh;
      const int tq = qt * 64 + th * 32 + l31;
      const long qrow = (long)b * T_ + tq;
      const bf16_t* pbrow = p.PB + qrow * PB_W - PA_W;
      bf16x8 qf[8];
      {
        const bf16_t* qp = pbrow + C_BQ + head * 128 + 8 * hi;
#pragma unroll
        for (int ks = 0; ks < 8; ++ks) qf[ks] = scale_bf16x8(*(const bf16x8*)(qp + 16 * ks), 0.08838834764831845f * LOG2E_F);
      }
      const float slope2 = exp2f(-0.5f * (float)(head + 1)) * LOG2E_F;
      const bf16_t gate_raw = pbrow[C_GT + head * 3 + 0];
      __syncthreads();
      int nv = tq >= 31 ? ((tq - 31) >> 4) : -1;
      if (nv > 126) nv = 126;
      f32x16 pr[4];
#pragma unroll
      for (int kt = 0; kt < 4; ++kt) {
        if (kt < nkt) {
          const float c0 = slope2 * (float)(16 * (32 * kt + 4 * hi) + 31 - tq);
#pragma unroll
          for (int r = 0; r < 16; ++r) pr[kt][r] = fmaf(slope2 * 16.0f, (float)((r & 3) + 8 * (r >> 2)), c0);
#pragma unroll
          for (int ks = 0; ks < 8; ++ks) {
            const bf16x8 a = *(const LAS bf16x8*)(lds + CP_K + (32 * kt + l31) * 272 + ks * 32 + hi * 16);
            pr[kt] = __builtin_amdgcn_mfma_f32_32x32x16_bf16(a, qf[ks], pr[kt], 0, 0, 0);
          }
#pragma unroll
          for (int r = 0; r < 16; ++r) if (32 * kt + (r & 3) + 8 * (r >> 2) + 4 * hi > nv) pr[kt][r] = NEG_INF_F;
        } else {
#pragma unroll
          for (int r = 0; r < 16; ++r) pr[kt][r] = NEG_INF_F;
        }
      }
      float mx = pr[0][0];
#pragma unroll
      for (int kt = 0; kt < 4; ++kt)
#pragma unroll
        for (int r = 0; r < 16; ++r) mx = fmaxf(mx, pr[kt][r]);
      mx = xhalf_max(mx);
      if (nv < 0) mx = 0.f;
      float ps = 0.f;
#pragma unroll
      for (int kt = 0; kt < 4; ++kt)
#pragma unroll
        for (int r = 0; r < 16; ++r) { pr[kt][r] = __builtin_amdgcn_exp2f(pr[kt][r] - mx); ps += pr[kt][r]; }
      ps = xhalf_sum(ps);
      const float inv = nv >= 0 ? 1.0f / ps : 0.f;
      {
        LAS float* imp = (LAS float*)(lds + CP_IMP) + ((th * 4 + hh) * 32 + l31) * 32;
        float eprev_same[4][4];
#pragma unroll
        for (int kt = 0; kt < 4; ++kt)
#pragma unroll
          for (int r4 = 0; r4 < 4; ++r4) eprev_same[kt][r4] = __shfl_xor(pr[kt][4 * r4 + 3], 32, 64);
#pragma unroll
        for (int kt = 0; kt < 4; ++kt)
#pragma unroll
          for (int r4 = 0; r4 < 4; ++r4) {
            const float gsum = (pr[kt][4 * r4] + pr[kt][4 * r4 + 1]) + (pr[kt][4 * r4 + 2] + pr[kt][4 * r4 + 3]);
            float e_hi0 = 0.f;
            if (r4 > 0) e_hi0 = eprev_same[kt][r4 - 1]; else if (kt > 0) e_hi0 = eprev_same[kt - 1][3];
            const float ep = hi ? eprev_same[kt][r4] : e_hi0;
            imp[8 * kt + 2 * r4 + hi] = (gsum + ep) * inv;
          }
      }
      f32x16 o[4];
#pragma unroll
      for (int db = 0; db < 4; ++db)
#pragma unroll
        for (int r = 0; r < 16; ++r) o[db][r] = 0.f;
#pragma unroll
      for (int kt = 0; kt < 4; ++kt) {
        if (kt < nkt) {
#pragma unroll
          for (int s = 0; s < 2; ++s) {
            const bf16x8 pf = pack_bf16x8(pr[kt], 8 * s);
#pragma unroll
            for (int db = 0; db < 4; ++db) {
              LAS unsigned char* vp = lds + CP_V + (32 * db + l31) * 272 + (32 * kt + 16 * s + 4 * hi) * 2;
              const u32x2v v0 = *(const LAS u32x2v*)(vp);
              const u32x2v v1 = *(const LAS u32x2v*)(vp + 16);
              const u32x4v vv = {v0[0], v0[1], v1[0], v1[1]};
              o[db] = __builtin_amdgcn_mfma_f32_32x32x16_bf16(__builtin_bit_cast(bf16x8, vv), pf, o[db], 0, 0, 0);
            }
          }
        }
      }
      {
        const float coef = fsigmoid_(bf2f(gate_raw)) * inv;
        float* yb = p.YB + qrow * 2048 + head * 128;
        f32x4 yv[4][4];
#pragma unroll
        for (int db = 0; db < 4; ++db)
#pragma unroll
          for (int r4 = 0; r4 < 4; ++r4) yv[db][r4] = *(const f32x4*)(yb + 32 * db + 8 * r4 + 4 * hi);
#pragma unroll
        for (int db = 0; db < 4; ++db)
#pragma unroll
          for (int r4 = 0; r4 < 4; ++r4) {
            f32x4 y = yv[db][r4];
#pragma unroll
            for (int i = 0; i < 4; ++i) y[i] += coef * o[db][4 * r4 + i];
            *(f32x4*)(yb + 32 * db + 8 * r4 + 4 * hi) = y;
          }
      }
      __syncthreads();
      {
        LAS float* impf = (LAS float*)(lds + CP_IMP);
        LAS float* sc = (LAS float*)(lds + CP_SC);
#pragma unroll
        for (int pass = 0; pass < 4; ++pass) {
          const int t = pass * 16 + (tid >> 5), j = tid & 31;
          const int th_ = t >> 5, tl = t & 31;
          float v = 0.f;
#pragma unroll
          for (int h4 = 0; h4 < 4; ++h4) v += impf[((th_ * 4 + h4) * 32 + tl) * 32 + j];
          float scv;
          if (j == 0 || j == qt || j == qt - 1) scv = 1e30f; else if (j <= qt) scv = v; else scv = -1e30f;
          sc[t * 36 + j] = scv;
        }
        __syncthreads();
#pragma unroll
        for (int pass = 0; pass < 4; ++pass) {
          const int t = pass * 16 + (tid >> 5), j = tid & 31;
          const float sj = sc[t * 36 + j];
          f32x4 sr[8];
#pragma unroll
          for (int i = 0; i < 8; ++i) sr[i] = *(const LAS f32x4*)(sc + t * 36 + 4 * i);
          __builtin_amdgcn_sched_barrier(0);
          int cnt = 0;
#pragma unroll
          for (int i = 0; i < 32; ++i) { const float si = sr[i >> 2][i & 3]; cnt += (si > sj || (si == sj && i < j)) ? 1 : 0; }
          const unsigned long long bal = __ballot(cnt < 16);
          if ((lane & 31) == 0) p.SELM[((long)b * T_ + qt * 64 + t) * 4 + g] = (int)(unsigned)(hi ? (bal >> 32) : bal);
        }
      }
      __syncthreads();
    }
  }
}


constexpr int HF_TOT = 0, HF_E1 = 4096, HF_E2 = 4608, HF_QT = 5120, HF_KT = HF_QT + 17408, HF_KTT = HF_KT + 17408,
              HF_VTT = HF_KTT + 18432, HF_SPT = HF_VTT + 18432, HF_SS = HF_SPT + 34816, HF_QHT = HF_SS + 2048,
              HF_GN = 131072;

__device__ __forceinline__ void hgrn_emit(const Params& p, const int e, LAS unsigned char* lds, const f32x16& O, const u32x2v (&gz)[4],
                                          const long row, const int h, const int th, const int vq, const int l31, const int hi, const int par) {
  const int t = 32 * th + l31 + par * 256;
  const float ss = (*(const LAS float*)(lds + HF_SS + (0 * 64 + t) * 4) + *(const LAS float*)(lds + HF_SS + (1 * 64 + t) * 4)) +
                   (*(const LAS float*)(lds + HF_SS + (2 * 64 + t) * 4) + *(const LAS float*)(lds + HF_SS + (3 * 64 + t) * 4));
  const float rstd = __builtin_amdgcn_rsqf(ss * (1.0f / 128) + NORM_EPS);
#pragma unroll
  for (int r4 = 0; r4 < 4; ++r4) {
    const int c = h * 128 + 32 * vq + 8 * r4 + 4 * hi;
    const f32x4 gn = *(const LAS f32x4*)(lds + HF_GN + (32 * vq + 8 * r4 + 4 * hi) * 4);
    const float z0 = u_as_f(gz[r4][0] << 16), z1 = u_as_f(gz[r4][0] & 0xFFFF0000u), z2 = u_as_f(gz[r4][1] << 16), z3 = u_as_f(gz[r4][1] & 0xFFFF0000u);
    u32x2v w;
    w[0] = pg8::cvt_pk_bf16(O[4 * r4 + 0] * rstd * gn[0] * fsilu_(z0), O[4 * r4 + 1] * rstd * gn[1] * fsilu_(z1));
    w[1] = pg8::cvt_pk_bf16(O[4 * r4 + 2] * rstd * gn[2] * fsilu_(z2), O[4 * r4 + 3] * rstd * gn[3] * fsilu_(z3));
    *(u32x2v*)(p.Ymix + row * 4096 + c) = w;
  }
}

__device__ __forceinline__ void hgrn_full_phase(const Params& p, const int e, LAS unsigned char* lds, const int tid, const int wid) {
  const int lane = tid & 63, l31 = lane & 31, hi = lane >> 5;
  const int item = blockIdx.x;
  const int h = item & 15, b = item >> 4;
  const int k0 = 2 * lane, rg = wid;
  const int vq = wid & 3, wg = wid >> 2;
  LAS float* TOT = (LAS float*)(lds + HF_TOT);
  LAS float* E1 = (LAS float*)(lds + HF_E1);
  LAS float* E2 = (LAS float*)(lds + HF_E2);
  if (tid < 128) *(LAS float*)(lds + HF_GN + tid * 4) = p.hgrn_norm_w[e * 2048 + h * 128 + tid];
  f32x16 S0, S1, O, Op;
#pragma unroll
  for (int r = 0; r < 16; ++r) { S0[r] = 0.f; S1[r] = 0.f; O[r] = 0.f; Op[r] = 0.f; }
  pg8::f32x2_t lf[8]; unsigned qs[8], kk[8]; u32x4v vreg[2]; u32x2v gz[4];
  const float* LFp = p.LF + ((long)b * T_ + 8 * rg) * 2048 + h * 128 + k0;
  const bf16_t* QSp = p.QS + ((long)b * T_ + 8 * rg) * 2048 + h * 128 + k0;
  const bf16_t* KKp = p.KK + ((long)b * T_ + 8 * rg) * 2048 + h * 128 + k0;
  const bf16_t* AVp0 = p.AVT + (((long)b * 16 + h) * 128 + (tid >> 3)) * T_ + (tid & 7) * 8;
  const bf16_t* AVp1 = AVp0 + (long)64 * T_;
  const bf16_t* GZp = p.PB + ((long)b * T_ + 32 * wg + l31) * PB_W + (C_AG - PA_W) + h * 128 + 32 * vq + 4 * hi;
#pragma unroll
  for (int i = 0; i < 8; ++i) { lf[i] = *(const pg8::f32x2_t*)(LFp + (long)i * 2048); qs[i] = *(const unsigned*)(QSp + (long)i * 2048); kk[i] = *(const unsigned*)(KKp + (long)i * 2048); }
  vreg[0] = *(const u32x4v*)(AVp0); vreg[1] = *(const u32x4v*)(AVp1);
  for (int c = 0; c < 32; ++c) {
    pg8::f32x2_t cs[8];
    cs[0] = lf[0];
#pragma unroll
    for (int i = 1; i < 8; ++i) { cs[i].x = cs[i - 1].x + lf[i].x; cs[i].y = cs[i - 1].y + lf[i].y; }
    *(LAS pg8::f32x2_t*)(lds + HF_TOT + (rg * 128 + k0) * 4) = cs[7];
    __syncthreads();
    const int cn = c + 1 < 32 ? c + 1 : 31;
    {
#pragma unroll
      for (int i = 0; i < 8; ++i) lf[i] = *(const pg8::f32x2_t*)(LFp + (long)cn * 64 * 2048 + (long)i * 2048);
    }
    {
      pg8::f32x2_t off = {0.f, 0.f}, R = {0.f, 0.f}, GL = {0.f, 0.f};
#pragma unroll
      for (int g8 = 0; g8 < 8; ++g8) {
        const pg8::f32x2_t tv = *(const LAS pg8::f32x2_t*)(lds + HF_TOT + (g8 * 128 + k0) * 4);
        if (g8 < rg) { off.x += tv.x; off.y += tv.y; }
        if (g8 < 4) { R.x += tv.x; R.y += tv.y; }
        GL.x += tv.x; GL.y += tv.y;
      }
      if (rg == 0) {
        *(LAS pg8::f32x2_t*)(lds + HF_E1 + k0 * 4) = (pg8::f32x2_t){fexp_(GL.x), fexp_(GL.y)};
        *(LAS pg8::f32x2_t*)(lds + HF_E2 + k0 * 4) = (pg8::f32x2_t){fexp_(GL.x - R.x), fexp_(GL.y - R.y)};
      }
      const pg8::f32x2_t eR = {fexp_(R.x), fexp_(R.y)};
      unsigned kta[4], ktb[4];
      unsigned short klo[8], khi[8];
#pragma unroll
      for (int i = 0; i < 8; ++i) {
        const float Gx = off.x + cs[i].x, Gy = off.y + cs[i].y;
        const float qx = u_as_f(qs[i] << 16) * fexp_(Gx - R.x), qy = u_as_f(qs[i] & 0xFFFF0000u) * fexp_(Gy - R.y);
        const float kx = u_as_f(kk[i] << 16) * fexp_(R.x - Gx), ky = u_as_f(kk[i] & 0xFFFF0000u) * fexp_(R.y - Gy);
        const unsigned qp = pg8::cvt_pk_bf16(qx, qy), kp = pg8::cvt_pk_bf16(kx, ky);
        *(LAS unsigned*)(lds + HF_QT + (8 * rg + i) * 272 + k0 * 2) = qp;
        *(LAS unsigned*)(lds + HF_QHT + (8 * rg + i) * 272 + k0 * 2) = pg8::cvt_pk_bf16(qx * eR.x, qy * eR.y);
        *(LAS unsigned*)(lds + HF_KT + (8 * rg + i) * 272 + k0 * 2) = kp;
        klo[i] = (unsigned short)(kp & 0xFFFFu); khi[i] = (unsigned short)(kp >> 16);
      }
#pragma unroll
      for (int i = 0; i < 4; ++i) { kta[i] = (unsigned)klo[2 * i] | ((unsigned)klo[2 * i + 1] << 16); ktb[i] = (unsigned)khi[2 * i] | ((unsigned)khi[2 * i + 1] << 16); }
      *(LAS u32x4v*)(lds + HF_KTT + k0 * 144 + rg * 16) = (u32x4v){kta[0], kta[1], kta[2], kta[3]};
      *(LAS u32x4v*)(lds + HF_KTT + (k0 + 1) * 144 + rg * 16) = (u32x4v){ktb[0], ktb[1], ktb[2], ktb[3]};
      *(LAS u32x4v*)(lds + HF_VTT + (tid >> 3) * 144 + (tid & 7) * 16) = vreg[0];
      *(LAS u32x4v*)(lds + HF_VTT + (64 + (tid >> 3)) * 144 + (tid & 7) * 16) = vreg[1];
#pragma unroll
      for (int tt = 0; tt < 2; ++tt) {
        const int kq = 2 * wg + tt;
#pragma unroll
        for (int r4 = 0; r4 < 4; ++r4) {
          const int kb = 32 * kq + 8 * r4 + 4 * hi;
          u32x2v w;
          if (tt == 0) {
            w[0] = pg8::cvt_pk_bf16(S0[4 * r4 + 0], S0[4 * r4 + 1]); w[1] = pg8::cvt_pk_bf16(S0[4 * r4 + 2], S0[4 * r4 + 3]);
          } else {
            w[0] = pg8::cvt_pk_bf16(S1[4 * r4 + 0], S1[4 * r4 + 1]); w[1] = pg8::cvt_pk_bf16(S1[4 * r4 + 2], S1[4 * r4 + 3]);
          }
          *(LAS u32x2v*)(lds + HF_SPT + (32 * vq + l31) * 272 + kb * 2) = w;
        }
      }
    }
    {
      const long adv = (long)cn * 64 * 2048;
#pragma unroll
      for (int i = 0; i < 8; ++i) { qs[i] = *(const unsigned*)(QSp + adv + (long)i * 2048); kk[i] = *(const unsigned*)(KKp + adv + (long)i * 2048); }
      vreg[0] = *(const u32x4v*)(AVp0 + cn * 64); vreg[1] = *(const u32x4v*)(AVp1 + cn * 64);
    }
    __syncthreads();
    if (c > 0) hgrn_emit(p, e, lds, Op, gz, (long)b * T_ + (c - 1) * 64 + 32 * wg + l31, h, wg, vq, l31, hi, (c - 1) & 1);
#pragma unroll
    for (int r4 = 0; r4 < 4; ++r4) gz[r4] = *(const u32x2v*)(GZp + (long)c * 64 * PB_W + 8 * r4);
    {
#pragma unroll
      for (int r = 0; r < 16; ++r) O[r] = 0.f;
#pragma unroll
      for (int ks = 0; ks < 8; ++ks) {
        const bf16x8 a = *(const LAS bf16x8*)(lds + HF_SPT + (32 * vq + l31) * 272 + ks * 32 + hi * 16);
        const bf16x8 bb = *(const LAS bf16x8*)(lds + HF_QHT + (32 * wg + l31) * 272 + ks * 32 + hi * 16);
        O = __builtin_amdgcn_mfma_f32_32x32x16_bf16(a, bb, O, 0, 0, 0);
      }
      for (int sh = 0; sh <= wg; ++sh) {
        f32x16 X;
#pragma unroll
        for (int r = 0; r < 16; ++r) X[r] = 0.f;
#pragma unroll
        for (int ks = 0; ks < 8; ++ks) {
          const bf16x8 a = *(const LAS bf16x8*)(lds + HF_KT + (32 * sh + l31) * 272 + ks * 32 + hi * 16);
          const bf16x8 bb = *(const LAS bf16x8*)(lds + HF_QT + (32 * wg + l31) * 272 + ks * 32 + hi * 16);
          X = __builtin_amdgcn_mfma_f32_32x32x16_bf16(a, bb, X, 0, 0, 0);
        }
        if (sh == wg) {
#pragma unroll
          for (int r = 0; r < 16; ++r) if ((r & 3) + 8 * (r >> 2) + 4 * hi > l31) X[r] = 0.f;
        }
#pragma unroll
        for (int s2 = 0; s2 < 2; ++s2) {
          const bf16x8 xp = pack_bf16x8(X, 8 * s2);
          LAS unsigned char* vp = lds + HF_VTT + (32 * vq + l31) * 144 + (32 * sh + 16 * s2 + 4 * hi) * 2;
          const u32x2v v0 = *(const LAS u32x2v*)(vp), v1 = *(const LAS u32x2v*)(vp + 16);
          const u32x4v vv = {v0[0], v0[1], v1[0], v1[1]};
          O = __builtin_amdgcn_mfma_f32_32x32x16_bf16(__builtin_bit_cast(bf16x8, vv), xp, O, 0, 0, 0);
        }
      }
      {
        float sq = 0.f;
#pragma unroll
        for (int r = 0; r < 16; ++r) sq += O[r] * O[r];
        sq = xhalf_sum(sq);
        if (hi == 0) *(LAS float*)(lds + HF_SS + ((c & 1) * 256 + vq * 64 + 32 * wg + l31) * 4) = sq;
        Op = O;
      }
#pragma unroll
      for (int tt = 0; tt < 2; ++tt) {
        const int kq = 2 * wg + tt;
        f32x16 W;
#pragma unroll
        for (int r = 0; r < 16; ++r) W[r] = 0.f;
#pragma unroll
        for (int ss = 0; ss < 4; ++ss) {
          const bf16x8 a = *(const LAS bf16x8*)(lds + HF_KTT + (32 * kq + l31) * 144 + ss * 32 + hi * 16);
          const bf16x8 bb = *(const LAS bf16x8*)(lds + HF_VTT + (32 * vq + l31) * 144 + ss * 32 + hi * 16);
          W = __builtin_amdgcn_mfma_f32_32x32x16_bf16(a, bb, W, 0, 0, 0);
        }
#pragma unroll
        for (int r4 = 0; r4 < 4; ++r4) {
          const int kb = 32 * kq + 8 * r4 + 4 * hi;
          const f32x4 e1 = *(const LAS f32x4*)(lds + HF_E1 + kb * 4), e2 = *(const LAS f32x4*)(lds + HF_E2 + kb * 4);
#pragma unroll
          for (int i = 0; i < 4; ++i) {
            if (tt == 0) S0[4 * r4 + i] = e1[i] * S0[4 * r4 + i] + e2[i] * W[4 * r4 + i];
            else S1[4 * r4 + i] = e1[i] * S1[4 * r4 + i] + e2[i] * W[4 * r4 + i];
          }
        }
      }
    }
  }
  __syncthreads();
  hgrn_emit(p, e, lds, Op, gz, (long)b * T_ + 31 * 64 + 32 * wg + l31, h, wg, vq, l31, hi, 1);
  __syncthreads();
}

template <int MODE>
__device__ __forceinline__ void attn_phase(const Params& p, LAS unsigned char* lds, const int tid) {
  const int wid = __builtin_amdgcn_readfirstlane(tid >> 6), lane = tid & 63, l31 = lane & 31, hi = lane >> 5;
  const int hh = wid >> 1, th = wid & 1;
  LAS unsigned* umask_p = (LAS unsigned*)(lds + 2 * AT_BUF);
  const float NEG_INF_F = -__builtin_inff();
  const int u0 = MODE == 0 ? (int)blockIdx.x - 80 : (int)blockIdx.x, ustep = MODE == 0 ? 176 : NBLK, uend = MODE == 0 ? 512 : 256;
  for (int u = u0; u < uend; u += ustep) {
    for (int half = 0; half < (MODE == 0 ? 1 : 2); ++half) {
      const int it = MODE == 0 ? u : (half ? 511 - u : u);
      const int qt = 31 - (it >> 4), bg = it & 15, b = bg >> 2, g = bg & 3;
      const int head = g * 4 + hh;
      const int tq = qt * 64 + th * 32 + l31;
      const long qrow = (long)b * T_ + tq;
      const bf16_t* pbrow = p.PB + qrow * PB_W - PA_W;
      bf16x8 qf[8];
      {
        const bf16_t* qp = pbrow + C_BQ + head * 128 + 8 * hi;
#pragma unroll
        for (int ks = 0; ks < 8; ++ks) qf[ks] = scale_bf16x8(*(const bf16x8*)(qp + 16 * ks), 0.08838834764831845f * LOG2E_F);
      }
      const float slope2 = exp2f(-0.5f * (float)(head + 1)) * LOG2E_F;
      const bf16_t gate_raw = pbrow[C_GT + head * 3 + (MODE == 0 ? 2 : 1)];
      const unsigned selm = MODE == 0 ? 0u : (unsigned)p.SELM[qrow * 4 + g];
      unsigned wor = selm;
#pragma unroll
      for (int off = 1; off < 32; off <<= 1) wor |= (unsigned)__shfl_xor((int)wor, off, 64);
      unsigned um = 0u;
      if (MODE != 0) {
        if (tid == 0) *umask_p = 0u;
        __syncthreads();
        if (lane == 0) atomicOr((unsigned*)umask_p, wor);
        __syncthreads();
        um = *umask_p;
      }
      for (int br = (MODE == 0 ? 1 : 0); br < (MODE == 0 ? 2 : 1); ++br) {
        unsigned todo;
        const bf16_t* Kb; const bf16_t* VTb; int W;
        if (br == 0) {
          todo = um & (qt == 31 ? 0xFFFFFFFFu : ((2u << qt) - 1u));
          Kb = p.PB + (long)b * T_ * PB_W + (C_KS - PA_W) + g * 128;
          VTb = p.VT + ((long)(0 * NB + b) * 4 + g) * 128 * T_;
          W = 1 << 20;
        } else {
          const int lo = qt - 8 < 0 ? 0 : qt - 8;
          todo = (qt == 31 ? 0xFFFFFFFFu : ((2u << qt) - 1u)) & ~((1u << lo) - 1u);
          Kb = p.PB + (long)b * T_ * PB_W + (C_KW - PA_W) + g * 128;
          VTb = p.VT + ((long)(1 * NB + b) * 4 + g) * 128 * T_;
          W = 512;
        }
        float m = -1e30f, l = 0.f;
        f32x16 o[4];
#pragma unroll
        for (int db = 0; db < 4; ++db)
#pragma unroll
          for (int r = 0; r < 16; ++r) o[db][r] = 0.f;
        u32x4v kreg[2], vreg[2];
        int j = __builtin_ctz(todo);
        todo &= todo - 1u;
#pragma unroll
        for (int i = 0; i < 2; ++i) {
          const int c = tid + i * 512;
          kreg[i] = *(const u32x4v*)(Kb + (long)(j * 64 + (c >> 4)) * PB_W + (c & 15) * 8);
          vreg[i] = *(const u32x4v*)(VTb + (long)(c >> 3) * T_ + j * 64 + (c & 7) * 8);
        }
#pragma unroll
        for (int i = 0; i < 2; ++i) {
          const int c = tid + i * 512;
          *(LAS u32x4v*)(lds + (c >> 4) * AT_KSTR + (c & 15) * 16) = kreg[i];
          LAS unsigned char* vp = lds + AT_KBYTES + (c >> 3) * AT_VSTR + (c & 7) * 16;
          *(LAS u32x2v*)(vp) = (u32x2v){vreg[i][0], vreg[i][1]};
          *(LAS u32x2v*)(vp + 8) = (u32x2v){vreg[i][2], vreg[i][3]};
        }
        __syncthreads();
        int cur = 0;
        for (;;) {
          const int jn = todo ? __builtin_ctz(todo) : -1;
          todo &= todo - 1u;
          if (jn >= 0) {
#pragma unroll
            for (int i = 0; i < 2; ++i) {
              const int c = tid + i * 512;
              kreg[i] = *(const u32x4v*)(Kb + (long)(jn * 64 + (c >> 4)) * PB_W + (c & 15) * 8);
              vreg[i] = *(const u32x4v*)(VTb + (long)(c >> 3) * T_ + jn * 64 + (c & 7) * 8);
            }
          }
          {
            LAS unsigned char* kb_ = lds + cur * AT_BUF;
            LAS unsigned char* vb_ = kb_ + AT_KBYTES;
            const int kb = j * 64 - tq;
            const float c0 = slope2 * (float)(kb + 4 * hi);
            f32x16 p0, p1;
#pragma unroll
            for (int r = 0; r < 16; ++r) {
              const float kc = (float)((r & 3) + 8 * (r >> 2));
              p0[r] = fmaf(slope2, kc, c0);
              p1[r] = fmaf(slope2, kc + 32.f, c0);
            }
#pragma unroll
            for (int ks = 0; ks < 8; ++ks) {
              const bf16x8 a0 = *(const LAS bf16x8*)(kb_ + l31 * AT_KSTR + ks * 32 + hi * 16);
              const bf16x8 a1 = *(const LAS bf16x8*)(kb_ + (32 + l31) * AT_KSTR + ks * 32 + hi * 16);
              p0 = __builtin_amdgcn_mfma_f32_32x32x16_bf16(a0, qf[ks], p0, 0, 0, 0);
              p1 = __builtin_amdgcn_mfma_f32_32x32x16_bf16(a1, qf[ks], p1, 0, 0, 0);
            }
            __builtin_amdgcn_sched_group_barrier(0x100, 6, 0);
#pragma unroll
            for (int q_ = 0; q_ < 10; ++q_) { __builtin_amdgcn_sched_group_barrier(0x008, 1, 0); __builtin_amdgcn_sched_group_barrier(0x100, 1, 0); }
            __builtin_amdgcn_sched_group_barrier(0x008, 6, 0);
            const bool boundary = (j == qt) || (br == 1 && j == qt - 8);
            if (boundary) {
              const int dq = -kb - 4 * hi;
#pragma unroll
              for (int r = 0; r < 16; ++r) {
                const int c = (r & 3) + 8 * (r >> 2);
                if ((unsigned)(dq - c) >= (unsigned)W) p0[r] = NEG_INF_F;
                if ((unsigned)(dq - c - 32) >= (unsigned)W) p1[r] = NEG_INF_F;
              }
            }
            if (br == 0 && !((selm >> j) & 1u)) {
#pragma unroll
              for (int r = 0; r < 16; ++r) { p0[r] = NEG_INF_F; p1[r] = NEG_INF_F; }
            }
            float mx = p0[0];
#pragma unroll
            for (int r = 1; r < 16; ++r) mx = fmaxf(mx, p0[r]);
#pragma unroll
            for (int r = 0; r < 16; ++r) mx = fmaxf(mx, p1[r]);
            mx = xhalf_max(mx);
            const float mn = fmaxf(m, mx);
            const float alpha = __builtin_amdgcn_exp2f(m - mn);
            m = mn;
            float ps = 0.f;
#pragma unroll
            for (int r = 0; r < 16; ++r) { p0[r] = __builtin_amdgcn_exp2f(p0[r] - mn); ps += p0[r]; }
#pragma unroll
            for (int r = 0; r < 16; ++r) { p1[r] = __builtin_amdgcn_exp2f(p1[r] - mn); ps += p1[r]; }
            l = l * alpha + ps;
#pragma unroll
            for (int db = 0; db < 4; ++db)
#pragma unroll
              for (int r = 0; r < 16; ++r) o[db][r] *= alpha;
            bf16x8 pf[4];
            pf[0] = pack_bf16x8(p0, 0); pf[1] = pack_bf16x8(p0, 8); pf[2] = pack_bf16x8(p1, 0); pf[3] = pack_bf16x8(p1, 8);
#pragma unroll
            for (int db = 0; db < 4; ++db) {
#pragma unroll
              for (int s4 = 0; s4 < 4; ++s4) {
                LAS unsigned char* vp = vb_ + (32 * db + l31) * AT_VSTR + (16 * s4 + 4 * hi) * 2;
                const u32x2v v0 = *(const LAS u32x2v*)(vp);
                const u32x2v v1 = *(const LAS u32x2v*)(vp + 16);
                const u32x4v vv = {v0[0], v0[1], v1[0], v1[1]};
                o[db] = __builtin_amdgcn_mfma_f32_32x32x16_bf16(__builtin_bit_cast(bf16x8, vv), pf[s4], o[db], 0, 0, 0);
              }
            }
            __builtin_amdgcn_sched_group_barrier(0x100, 6, 1);
#pragma unroll
            for (int q_ = 0; q_ < 10; ++q_) { __builtin_amdgcn_sched_group_barrier(0x008, 1, 1); __builtin_amdgcn_sched_group_barrier(0x100, 1, 1); }
            __builtin_amdgcn_sched_group_barrier(0x008, 6, 1);
          }
          if (jn < 0) break;
          {
            LAS unsigned char* nb_ = lds + (cur ^ 1) * AT_BUF;
#pragma unroll
            for (int i = 0; i < 2; ++i) {
              const int c = tid + i * 512;
              *(LAS u32x4v*)(nb_ + (c >> 4) * AT_KSTR + (c & 15) * 16) = kreg[i];
              LAS unsigned char* vp = nb_ + AT_KBYTES + (c >> 3) * AT_VSTR + (c & 7) * 16;
              *(LAS u32x2v*)(vp) = (u32x2v){vreg[i][0], vreg[i][1]};
              *(LAS u32x2v*)(vp + 8) = (u32x2v){vreg[i][2], vreg[i][3]};
            }
          }
          __syncthreads();
          cur ^= 1;
          j = jn;
        }
        __syncthreads();
        {
          const float lt = xhalf_sum(l);
          const float gate = sigmoidf_(bf2f(gate_raw));
          const float coef = gate / lt;
          LAS unsigned char* orow = lds + (wid * 32 + l31) * AT_OSTR + 16 * hi;
#pragma unroll
          for (int db = 0; db < 4; ++db) {
#pragma unroll
            for (int r4 = 0; r4 < 4; ++r4) {
              f32x4 y;
#pragma unroll
              for (int i = 0; i < 4; ++i) y[i] = coef * o[db][4 * r4 + i];
              *(LAS f32x4*)(orow + (32 * db + 8 * r4) * 4) = y;
            }
          }
        }
        __syncthreads();
        {
          const int hsel = lane >> 5, dd = (lane & 31) * 4;
          const long trow0 = (long)b * T_ + qt * 64 + wid * 8;
#pragma unroll
          for (int hp = 0; hp < 2; ++hp) {
            const int hh2 = hp * 2 + hsel;
            f32x4 yv[8]; u32x2v gv[8];
            if (MODE != 0) {
#pragma unroll
              for (int k = 0; k < 8; ++k) {
                const long tr = trow0 + k;
                yv[k] = *(const f32x4*)(p.YB + tr * 2048 + (g * 4 + hh2) * 128 + dd);
                gv[k] = *(const u32x2v*)(p.PB + tr * PB_W - PA_W + C_BG + (g * 4 + hh2) * 128 + dd);
              }
            }
#pragma unroll
            for (int k = 0; k < 8; ++k) {
              const int t = wid * 8 + k;
              const f32x4 v = *(const LAS f32x4*)(lds + ((hh2 * 2 + (t >> 5)) * 32 + (t & 31)) * AT_OSTR + dd * 4);
              const long tr = trow0 + k;
              if (MODE == 0) {
                *(f32x4*)(p.YB + tr * 2048 + (g * 4 + hh2) * 128 + dd) = v;
              } else {
                f32x4 y = yv[k];
#pragma unroll
                for (int i = 0; i < 4; ++i) y[i] += v[i];
                const u32x2v gz = gv[k];
                const float z0 = u_as_f(gz[0] << 16), z1 = u_as_f(gz[0] & 0xFFFF0000u), z2 = u_as_f(gz[1] << 16), z3 = u_as_f(gz[1] & 0xFFFF0000u);
                u32x2v w;
                w[0] = pg8::cvt_pk_bf16(y[0] * fsilu_(z0), y[1] * fsilu_(z1));
                w[1] = pg8::cvt_pk_bf16(y[2] * fsilu_(z2), y[3] * fsilu_(z3));
                *(u32x2v*)(p.Ymix + tr * 4096 + 2048 + (g * 4 + hh2) * 128 + dd) = w;
              }
            }
          }
        }
        __syncthreads();
      }
    }
  }
}


constexpr int LDS_BYTES = 147456;


__device__ __forceinline__ float wave_sum(float v) {
#pragma unroll
  for (int off = 32; off >= 1; off >>= 1) v += __shfl_xor(v, off, 64);
  return v;
}
template <bool FINAL, bool COPY>
__device__ __forceinline__ void rmsnorm_phase(const float* __restrict__ src, float* __restrict__ X, const float* __restrict__ w,
                                              bf16_t* __restrict__ Hb, float* __restrict__ out, const int tid, const int wid) {
  const int lane = tid & 63;
  for (int row = blockIdx.x * 8 + wid; row < M_; row += NBLK * 8) {
    const float* xr = src + (size_t)row * D_;
    f32x4 v[8];
    float ss = 0.f;
#pragma unroll
    for (int i = 0; i < 8; ++i) {
      v[i] = *(const f32x4*)(xr + lane * 4 + 256 * i);
      ss += v[i][0] * v[i][0] + v[i][1] * v[i][1] + v[i][2] * v[i][2] + v[i][3] * v[i][3];
    }
    ss = wave_sum(ss);
    const float rstd = 1.0f / sqrtf(ss * (1.0f / D_) + NORM_EPS);
#pragma unroll
    for (int i = 0; i < 8; ++i) {
      const int c = lane * 4 + 256 * i;
      const f32x4 ww = *(const f32x4*)(w + c);
      if (COPY) *(f32x4*)(X + (size_t)row * D_ + c) = v[i];
      if (FINAL) {
        f32x4 o;
#pragma unroll
        for (int j = 0; j < 4; ++j) o[j] = v[i][j] * rstd * ww[j];
        *(f32x4*)(out + (size_t)row * D_ + c) = o;
      } else {
        uint2 pk;
        pk.x = pg8::cvt_pk_bf16(v[i][0] * rstd * ww[0], v[i][1] * rstd * ww[1]);
        pk.y = pg8::cvt_pk_bf16(v[i][2] * rstd * ww[2], v[i][3] * rstd * ww[3]);
        *(uint2*)(Hb + (size_t)row * D_ + c) = pk;
      }
    }
  }
}
__device__ __forceinline__ void hgrn_post_phase(const Params& p, const int e, const int tid, const int wid) {
  const int lane = tid & 63;
  for (int u = blockIdx.x * 8 + wid; u < M_ * 16; u += NBLK * 8) {
    const long row = u >> 4; const int h = u & 15;
    const int c = h * 128 + 2 * lane;
    const float2 o = *(const float2*)(p.OA + row * 2048 + c);
    const float ss = wave_sum(o.x * o.x + o.y * o.y);
    const float rstd = 1.0f / sqrtf(ss * (1.0f / 128) + NORM_EPS);
    const float2 gn = *(const float2*)(p.hgrn_norm_w + e * 2048 + c);
    const unsigned gz = *(const unsigned*)(p.PB + row * PB_W + (C_AG - PA_W) + c);
    const float z0 = u_as_f(gz << 16), z1 = u_as_f(gz & 0xFFFF0000u);
    *(unsigned*)(p.Ymix + row * 4096 + c) = pg8::cvt_pk_bf16(o.x * rstd * gn.x * fsilu_(z0), o.y * rstd * gn.y * fsilu_(z1));
  }
}
__device__ void wg_convert(const float* __restrict__ w_a, const float* __restrict__ w_i, bf16_t* __restrict__ Wt_g, float* tile, int bid, int nblk, int tid) {
  for (int t = bid; t < 160; t += nblk) {
    const int mat = t >> 2, k0 = (t & 3) * 64, ai = mat & 1, on = mat >> 1;
    const float* W = (ai ? w_i : w_a) + (size_t)on * 65536;
    {
      const int r = tid >> 6, c4 = (tid & 63) * 4;
      f32x4 v[8];
#pragma unroll
      for (int i = 0; i < 8; ++i) v[i] = *(const f32x4*)(W + (size_t)(k0 + r + 8 * i) * 256 + c4);
#pragma unroll
      for (int i = 0; i < 8; ++i) {
        float* d = tile + (r + 8 * i) * 257 + c4;
        d[0] = v[i][0]; d[1] = v[i][1]; d[2] = v[i][2]; d[3] = v[i][3];
      }
    }
    __syncthreads();
#pragma unroll
    for (int i = 0; i < 4; ++i) {
      const int c = tid + 512 * i, n = c >> 3, kq = (c & 7) * 8;
      unsigned w[4];
#pragma unroll
      for (int j = 0; j < 4; ++j)
        w[j] = (unsigned)f2bf(tile[(kq + 2 * j) * 257 + n]) | ((unsigned)f2bf(tile[(kq + 2 * j + 1) * 257 + n]) << 16);
      const int drow = (n >> 7) * 256 + ai * 128 + (n & 127);
      *(uint4*)(Wt_g + ((size_t)on * 512 + drow) * 256 + k0 + kq) = make_uint4(w[0], w[1], w[2], w[3]);
    }
    __syncthreads();
  }
}
__device__ __forceinline__ void c1_partial(const Params& p, const int tid, const int wid) {
  const int lane = tid & 63;
  for (int u = blockIdx.x * 8 + wid; u < 256; u += NBLK * 8) {
    const int mat = u & 3, part = u >> 2, kv = mat & 1, l = mat >> 1;
    const float* pe = (kv ? p.cmp_pe_v : p.cmp_pe_k) + (long)l * 4096 + part * 64;
    const float* w1 = (kv ? p.cmp_w1_v : p.cmp_w1_k) + (long)l * 4096 * 128 + (long)part * 64 * 128 + 2 * lane;
    float a0 = 0.f, a1 = 0.f;
#pragma unroll 16
    for (int i = 0; i < 64; ++i) {
      const pg8::f32x2_t v = *(const pg8::f32x2_t*)(w1 + (long)i * 128);
      const float sc = pe[i];
      a0 += sc * v.x; a1 += sc * v.y;
    }
    *(pg8::f32x2_t*)(p.HID + (part * 4 + mat) * 128 + 2 * lane) = (pg8::f32x2_t){a0, a1};
  }
}
__device__ __forceinline__ void c1_reduce(const Params& p, const int tid) {
  float acc = 0.f;
#pragma unroll 16
  for (int part = 0; part < 64; ++part) acc += p.HID[part * 512 + tid];
  p.C1[tid] = acc;
}
__device__ __forceinline__ void c1_phase(const Params& p, const int tid, const int wid) {
  const int lane = tid & 63;
  for (int u = blockIdx.x * 8 + wid; u < 512; u += NBLK * 8) {
    const int e = u & 127, kv = (u >> 7) & 1, l = u >> 8;
    const float* pe = (kv ? p.cmp_pe_v : p.cmp_pe_k) + (long)l * 4096;
    const float* w1 = (kv ? p.cmp_w1_v : p.cmp_w1_k) + (long)l * 4096 * 128;
    float acc = 0.f;
    for (int i = lane; i < 4096; i += 64) acc += pe[i] * w1[(long)i * 128 + e];
    acc = wave_sum(acc);
    if (lane == 0) p.C1[u] = acc;
  }
}


__device__ __forceinline__ void conv_phase(const Params& p, const int o, const int tid) {
  const float* cw = p.rg_conv_w + (long)o * 4 * DR;
  const float* cb = p.rg_conv_b + (long)o * DR;
  for (int i = blockIdx.x * NTHREADS + tid; i < (M_ / 16) * 640; i += NBLK * NTHREADS) {
    const int rgp = i / 640, c = (i - rgp * 640) * 4, row0 = rgp * 16, t0 = row0 & (T_ - 1);
    const f32x4 bias = *(const f32x4*)(cb + c);
    const f32x4 w0 = *(const f32x4*)(cw + c), w1 = *(const f32x4*)(cw + DR + c), w2 = *(const f32x4*)(cw + 2 * DR + c), w3 = *(const f32x4*)(cw + 3 * DR + c);
    uint2 xr[19];
#pragma unroll
    for (int j = 0; j < 19; ++j) {
      xr[j] = make_uint2(0u, 0u);
      if (j >= 3 || t0 > 0) xr[j] = *(const uint2*)(p.XB + (long)(row0 + j - 3) * DR + c);
    }
    bf16_t* dst = p.XCb + ((long)(c >> 8) * M_ + row0) * 256 + (c & 255);
#pragma unroll
    for (int r = 0; r < 16; ++r) {
      f32x4 acc = bias;
      const f32x4 ws[4] = {w0, w1, w2, w3};
#pragma unroll
      for (int j = 0; j < 4; ++j) {
        const uint2 xw = xr[r + j];
        acc[0] += ws[j][0] * u_as_f(xw.x << 16); acc[1] += ws[j][1] * u_as_f(xw.x & 0xFFFF0000u);
        acc[2] += ws[j][2] * u_as_f(xw.y << 16); acc[3] += ws[j][3] * u_as_f(xw.y & 0xFFFF0000u);
      }
      uint2 w; w.x = pg8::cvt_pk_bf16(acc[0], acc[1]); w.y = pg8::cvt_pk_bf16(acc[2], acc[3]);
      *(uint2*)(dst + (long)r * 256) = w;
    }
  }
}


__device__ __forceinline__ void hidout_phase(const Params& p, const int e, LAS unsigned char* lds, const int tid, const int first, const int step) {
  LAS float* hs = (LAS float*)lds;
  LAS float* w2s = (LAS float*)(lds + 2048);
  {
    const float* wk = p.cmp_w2_k + (long)e * 128 * 128;
    const float* wv = p.cmp_w2_v + (long)e * 128 * 128;
    f32x4 a[8], c[8];
#pragma unroll
    for (int i = 0; i < 8; ++i) { a[i] = *(const f32x4*)(wk + 4 * (tid + 512 * i)); c[i] = *(const f32x4*)(wv + 4 * (tid + 512 * i)); }
#pragma unroll
    for (int i = 0; i < 8; ++i) { *(LAS f32x4*)(w2s + 4 * (tid + 512 * i)) = a[i]; *(LAS f32x4*)(w2s + 16384 + 4 * (tid + 512 * i)) = c[i]; }
  }
  __syncthreads();
  const int eo = tid & 127, rl = tid >> 7;
  for (int r4 = first; r4 < 2 * NB * 4 * NCMP / 4; r4 += step) {
    const int r = r4 * 4 + rl;
    const int n = r % NCMP, rb = r / NCMP, kv = rb / (NB * 4), bg = rb % (NB * 4);
    const float* z = p.ZC + ((long)rb * 128 + n) * 256;
    hs[tid] = fsilu_(z[eo] + z[256 + 128 + eo] + p.C1[(e * 2 + kv) * 128 + eo]);
    __syncthreads();
    LAS float* w2 = w2s + kv * 16384;
    float acc = 0.f;
#pragma unroll 16
    for (int i = 0; i < 128; ++i) acc += hs[rl * 128 + i] * w2[i * 128 + eo];
    if (kv) p.VCT[((long)bg * 128 + eo) * 128 + n] = f2bf(acc); else p.KCb[((long)bg * 128 + n) * 128 + eo] = f2bf(acc);
    if (n == 0) { if (kv) p.VCT[((long)bg * 128 + eo) * 128 + 127] = 0; else p.KCb[((long)bg * 128 + 127) * 128 + eo] = 0; }
    __syncthreads();
  }
}


__device__ __forceinline__ void unpack4(const uint2 w, float (&f)[4]) {
  f[0] = u_as_f(w.x << 16); f[1] = u_as_f(w.x & 0xFFFF0000u); f[2] = u_as_f(w.y << 16); f[3] = u_as_f(w.y & 0xFFFF0000u);
}
__device__ __forceinline__ void scan1_phase(const Params& p, const int tid) {
  for (int i = blockIdx.x * 320 + tid; tid < 320 && i < NB * 32 * 640; i += NBLK * 320) {
    const int cq = i % 640, r = i / 640, ch = r & 31, b = r >> 5;
    const long base = ((long)b * T_ + ch * 64) * DR + 4 * cq;
    float h[4] = {0.f, 0.f, 0.f, 0.f}, sl[4] = {0.f, 0.f, 0.f, 0.f};
#pragma unroll 16
    for (int t = 0; t < 64; ++t) {
      float la[4], uu[4];
      unpack4(*(const uint2*)(p.LA + base + (long)t * DR), la);
      unpack4(*(const uint2*)(p.UB + base + (long)t * DR), uu);
#pragma unroll
      for (int j = 0; j < 4; ++j) { h[j] = fexp_(la[j]) * h[j] + uu[j]; sl[j] += la[j]; }
    }
    const long so = ((long)b * 32 + ch) * DR + 4 * cq;
    *(f32x4*)(p.SUMP + so) = (f32x4){fexp_(sl[0]), fexp_(sl[1]), fexp_(sl[2]), fexp_(sl[3])};
    *(f32x4*)(p.SUMH + so) = (f32x4){h[0], h[1], h[2], h[3]};
  }
}
__device__ __forceinline__ void scan2_phase(const Params& p, const int tid) {
  for (int i = blockIdx.x * 320 + tid; tid < 320 && i < NB * 32 * 640; i += NBLK * 320) {
    const int cq = i % 640, r = i / 640, ch = r & 31, b = r >> 5;
    float h[4] = {0.f, 0.f, 0.f, 0.f};
#pragma unroll 8
    for (int cc = 0; cc < ch; ++cc) {
      const long so = ((long)b * 32 + cc) * DR + 4 * cq;
      const f32x4 P = *(const f32x4*)(p.SUMP + so), H = *(const f32x4*)(p.SUMH + so);
#pragma unroll
      for (int j = 0; j < 4; ++j) h[j] = P[j] * h[j] + H[j];
    }
    const long base = ((long)b * T_ + ch * 64) * DR + 4 * cq;
#pragma unroll 1
    for (int t0 = 0; t0 < 64; t0 += 16) {
      uint2 lav[16], uuv[16], gsv[16];
#pragma unroll
      for (int t = 0; t < 16; ++t) {
        lav[t] = *(const uint2*)(p.LA + base + (long)(t0 + t) * DR);
        uuv[t] = *(const uint2*)(p.UB + base + (long)(t0 + t) * DR);
        gsv[t] = *(const uint2*)(p.GS + base + (long)(t0 + t) * DR);
      }
#pragma unroll
      for (int t = 0; t < 16; ++t) {
        float la[4], uu[4], gs[4];
        unpack4(lav[t], la); unpack4(uuv[t], uu); unpack4(gsv[t], gs);
#pragma unroll
        for (int j = 0; j < 4; ++j) h[j] = fexp_(la[j]) * h[j] + uu[j];
        uint2 w; w.x = pg8::cvt_pk_bf16(h[0] * gs[0], h[1] * gs[1]); w.y = pg8::cvt_pk_bf16(h[2] * gs[2], h[3] * gs[3]);
        *(uint2*)(p.Ymix + base + (long)(t0 + t) * DR) = w;
      }
    }
  }
}

#define XB_TMO      128
#define XB_XCNT(j)  (256  + 64 * (j))
#define XB_XSUB(j)  (1280 + 64 * (j))
#define XB_XGEN(j)  (2304 + 64 * (j))
#define XB_TOP      3328
#define XB_TOPGEN   3392
#define XCD_BAR_WORDS 3456
#define XB_SPIN_CAP (1u << 20)
__device__ __forceinline__ unsigned xb_ld(unsigned* p)              { return __hip_atomic_load(p, __ATOMIC_RELAXED, __HIP_MEMORY_SCOPE_AGENT); }
__device__ __forceinline__ unsigned xb_add(unsigned* p, unsigned v) { return __hip_atomic_fetch_add(p, v, __ATOMIC_RELAXED, __HIP_MEMORY_SCOPE_AGENT); }
__device__ __forceinline__ unsigned xb_xcc_id() { return (unsigned)__builtin_amdgcn_s_getreg((3 << 11) | 20) & 0xFu; }
#define XB_SPIN(cond, bar) do { unsigned _sp = 0; while (cond) { __builtin_amdgcn_s_sleep(1); \
    if ((++_sp & 255u) == 0u) { if (xb_ld(&(bar)[XB_TMO])) break; if (_sp > XB_SPIN_CAP) { atomicAdd(&(bar)[XB_TMO], 1u); break; } } } } while (0)

__device__ __forceinline__ void xcd_barrier_complete(unsigned* bar, unsigned x, unsigned& nloc, unsigned& nx, const unsigned G) {
  unsigned sum, cnt, mine, sp = 0u;
  for (;;) {
    sum = 0u; cnt = 0u; mine = 0u;
#pragma unroll
    for (unsigned j = 0; j < 16; ++j) { const unsigned c = xb_ld(&bar[XB_XCNT(j)]); sum += c; cnt += (c > 0u) ? 1u : 0u; mine = (j == x) ? c : mine; }
    if (sum == G) break;
    __builtin_amdgcn_s_sleep(1);
    if ((++sp & 255u) == 0u) { if (xb_ld(&bar[XB_TMO])) break; if (sp > XB_SPIN_CAP) { atomicAdd(&bar[XB_TMO], 1u); break; } }
  }
  nloc = mine > 0u ? mine : 1u; nx = cnt > 0u ? cnt : 1u;
}
__device__ __forceinline__ void xcd_barrier(unsigned* bar, volatile LAS unsigned* st, const bool leader, const unsigned G) {
  asm volatile("s_waitcnt vmcnt(0)" ::: "memory");
  __syncthreads();
  if (leader) {
    const unsigned x = xb_xcc_id();
    __builtin_amdgcn_s_waitcnt(0);
    unsigned nloc = st[0], nx = st[1];
    if (nloc == 0u) { xcd_barrier_complete(bar, x, nloc, nx, G); st[0] = nloc; st[1] = nx; }
    const unsigned old = xb_add(&bar[XB_XSUB(x)], 1u);
    const unsigned gen = old / nloc;
    if (old + 1u == (gen + 1u) * nloc) {
      __builtin_amdgcn_fence(__ATOMIC_RELEASE, "agent");
      asm volatile("s_waitcnt vmcnt(0)" ::: "memory");
      const unsigned og = xb_add(&bar[XB_TOP], 1u);
      const unsigned tg = og / nx;
      if (og + 1u == (tg + 1u) * nx) xb_add(&bar[XB_TOPGEN], 1u);
      else XB_SPIN(xb_ld(&bar[XB_TOPGEN]) == tg, bar);
      __builtin_amdgcn_fence(__ATOMIC_ACQUIRE, "agent");
      xb_add(&bar[XB_XGEN(x)], 1u);
      asm volatile("s_waitcnt vmcnt(0)" ::: "memory");
    } else {
      XB_SPIN(xb_ld(&bar[XB_XGEN(x)]) == gen, bar);
      __builtin_amdgcn_fence(__ATOMIC_ACQUIRE, "agent");
      asm volatile("s_waitcnt vmcnt(0)" ::: "memory");
    }
  }
  __syncthreads();
}

__global__ void __launch_bounds__(NTHREADS, 2) mega(Params p_unused) {
  extern __shared__ __attribute__((aligned(16))) unsigned char lds[];

  const int wid_s = __builtin_amdgcn_readfirstlane((int)(threadIdx.x >> 6));
  const int bid_s = __builtin_amdgcn_readfirstlane((int)blockIdx.x);
  volatile LAS unsigned* bar_st = (volatile LAS unsigned*)((LAS unsigned char*)lds + LDS_BYTES - 16);
  volatile LAS unsigned* bar_st2 = (volatile LAS unsigned*)((LAS unsigned char*)lds + LDS_BYTES - 32);
  if (threadIdx.x == 0) { bar_st[0] = 0u; bar_st[1] = 0u; bar_st2[0] = 0u; bar_st2[1] = 0u; }
  __syncthreads();
  { const Params p = *kparams(); if (threadIdx.x == 0) { (void)xb_add(&p.BAR[XB_XCNT(xb_xcc_id())], 1u); if (bid_s >= 64) (void)xb_add(&p.BAR[XCD_BAR_WORDS + XB_XCNT(xb_xcc_id())], 1u); } }
#ifdef PROFILE_LEAK
  volatile LAS unsigned* prof = (volatile LAS unsigned*)((LAS unsigned char*)lds + LDS_BYTES - 128);
  if (threadIdx.x < 16) prof[threadIdx.x] = 0u;
  unsigned long long t_prev = __builtin_amdgcn_s_memrealtime();
  int cat_ = 0;
#define CAT(c) cat_ = (c)
#define GSYNC() do { const Params pb_ = *kparams(); xcd_barrier(pb_.BAR, bar_st, wid_s == 0 && opaque_lane() == 0, NBLK); \
    { const unsigned long long tn_ = __builtin_amdgcn_s_memrealtime(); if (wid_s == 0 && opaque_lane() == 0) prof[cat_] += (unsigned)(tn_ - t_prev); t_prev = tn_; } } while (0)
#else
#define CAT(c)
#define GSYNC() do { const Params pb_ = *kparams(); xcd_barrier(pb_.BAR, bar_st, wid_s == 0 && opaque_lane() == 0, NBLK); } while (0)
#endif
#define GSYNC_N() do { const Params pb_ = *kparams(); xcd_barrier(pb_.BAR + XCD_BAR_WORDS, bar_st2, wid_s == 0 && opaque_lane() == 0, 192u); } while (0)
#define RUN(kind, layer) do { const Params p = *kparams(); const int tid = opaque_tid(); const long n_ = stage_threads(kind); \
    for (long g_ = (long)bid_s * NTHREADS + tid; g_ < n_; g_ += (long)NBLK * NTHREADS) stage_thread(p, kind, layer, g_); GSYNC(); } while (0)
  {
    const Params p = *kparams(); const int tid = opaque_tid();
    float* tile = (float*)lds;
    const int nb = NBLK, bid = bid_s;
    wt_convert256(p.even_w_in, p.Wt_ein, D_, EIN, EIN_PAD, tile, bid, nb, tid);
    for (int l = 0; l < 2; ++l)
      for (int kv = 0; kv < 2; ++kv) {
        const float* w1 = (kv ? p.cmp_w1_v : p.cmp_w1_k) + (size_t)l * 4096 * 128;
        bf16_t* dst = p.W1T + (size_t)(l * 2 + kv) * 256 * 2048;
        wt_convert(w1, dst, 2048, 128, 128, tile, bid, nb, tid);
        wt_convert(w1 + (size_t)2048 * 128, dst + (size_t)128 * 2048, 2048, 128, 128, tile, bid, nb, tid);
      }
  }
  CAT(1);
  { const Params p = *kparams(); const int tid = opaque_tid();
    c1_partial(p, tid, wid_s);
    wg_convert(p.rg_w_a, p.rg_w_i, p.Wt_g, (float*)lds, (bid_s + 96) & 255, NBLK, tid);
    for (int g_ = bid_s * NTHREADS + tid; g_ < 2 * DR; g_ += NBLK * NTHREADS) p.SP[g_] = -8.0f * softplusf_(-p.rg_lambda[g_]);
    for (int g_ = bid_s * NTHREADS + tid; g_ < 2048; g_ += NBLK * NTHREADS) { p.LB[g_] = 0.f; p.LB[2048 + g_] = sigmoidf_(p.hgrn_lb_logits[2048 + g_] - p.hgrn_lb_logits[g_]); }
    rmsnorm_phase<false, false>(p.x, nullptr, p.norm_w, p.Hb, nullptr, tid, wid_s); }
  GSYNC();
#define LAYER_PAIR(e) { \
    const int le = 2 * e, lo = 2 * e + 1; \
    CAT(3); \
    { const Params p = *kparams(); pg8::Gemm g{p.Hb, p.Wt_ein + (size_t)e * EIN_PAD * D_, M_, EIN_PAD, D_}; pg8::StaticOrder S; S.init(M_, EIN_PAD, NBLK, bid_s); EpiEvenIn E{p.QS, p.LF, p.KK, p.AVT, p.LB + e * 2048, p.PB, p.VT, p.KVC}; \
      pg8::gemm_phase<EpiEvenIn, pg8::StaticOrder, GEMM_ALIGN, SP2_EIN>((LAS unsigned char*)lds, g, S, E, wid_s); } \
    if (bid_s >= 160) { const Params p = *kparams(); const int tid = opaque_tid(); float* tile = (float*)lds;     \
      if (e == 0) { \
        if (bid_s == 160) c1_reduce(p, tid); \
        wt_convert256(p.even_w_out, p.Wt_eout, 4096, D_, D_, tile, bid_s - 160, 96, tid); \
        wt_convert256(p.odd_w_in, p.Wt_oin, D_, OIN, OIN, tile, bid_s - 160, 96, tid); \
        wt_convert256(p.odd_w_out, p.Wt_oout, DR, D_, D_, tile, bid_s - 160, 96, tid); \
      } else { \
        wt_convert256(p.odd_w_in + (size_t)D_ * OIN, p.Wt_oin + (size_t)OIN * D_, D_, OIN, OIN, tile, bid_s - 160, 96, tid); \
        wt_convert256(p.odd_w_out + (size_t)DR * D_, p.Wt_oout + (size_t)D_ * DR, DR, D_, D_, tile, bid_s - 160, 96, tid); \
      } } \
    GSYNC(); CAT(4); \
    if (bid_s < 64) { const Params p = *kparams(); const int tid = opaque_tid(); hgrn_full_phase(p, e, (LAS unsigned char*)lds, tid, wid_s); } \
    else { \
      if (bid_s < 80) { const Params p = *kparams(); pg8::Gemm g{p.KVC, p.W1T + (size_t)e * 2 * 256 * 2048, 2 * NB * 4 * 128, 512, 2048}; CmpOrder S{16, bid_s - 64}; EpiZ E{p.ZC}; \
        pg8::gemm_phase<EpiZ, CmpOrder, GEMM_ALIGN, SP2_CMP>((LAS unsigned char*)lds, g, S, E, wid_s); } \
      else { const Params p = *kparams(); const int tid = opaque_tid(); attn_phase<0>(p, (LAS unsigned char*)lds, tid); } \
      GSYNC_N(); \
      { const Params p = *kparams(); const int tid = opaque_tid(); hidout_phase(p, e, (LAS unsigned char*)lds, tid, bid_s - 64, 192); } \
      GSYNC_N(); \
      { const Params p = *kparams(); const int tid = opaque_tid(); cmp_phase(p, (LAS unsigned char*)lds, tid, wid_s, bid_s - 64, 192); } \
    } \
    GSYNC(); CAT(9); \
    { const Params p = *kparams(); const int tid = opaque_tid(); attn_phase<1>(p, (LAS unsigned char*)lds, tid); } \
    GSYNC(); CAT(10); \
    { const Params p = *kparams(); pg8::Gemm g{p.Ymix, p.Wt_eout + (size_t)e * D_ * 4096, M_, D_, 4096}; pg8::StaticOrder S; S.init(M_, D_, NBLK, bid_s); EpiAccumF32 E{p.X, D_, e == 0 ? p.x : (const float*)p.X}; \
      pg8::gemm_phase<EpiAccumF32, pg8::StaticOrder, GEMM_ALIGN, SP2_OUT>((LAS unsigned char*)lds, g, S, E, wid_s); } \
    GSYNC(); CAT(2); \
    { const Params p = *kparams(); const int tid = opaque_tid(); rmsnorm_phase<false, false>(p.X, nullptr, p.norm_w + lo * D_, p.Hb, nullptr, tid, wid_s); } \
    GSYNC(); CAT(11); \
    { const Params p = *kparams(); pg8::Gemm g{p.Hb, p.Wt_oin + (size_t)e * OIN * D_, M_, OIN, D_}; pg8::StaticOrder S; S.init(M_, OIN, NBLK, bid_s); EpiOddIn E{p.XB, p.GS}; \
      pg8::gemm_phase<EpiOddIn, pg8::StaticOrder, GEMM_ALIGN, SP2_OIN>((LAS unsigned char*)lds, g, S, E, wid_s); } \
    if (e == 0 && bid_s >= 128) { const Params p = *kparams(); const int tid = opaque_tid(); float* tile = (float*)lds; \
      wt_convert256(p.even_w_in + (size_t)D_ * EIN, p.Wt_ein + (size_t)EIN_PAD * D_, D_, EIN, EIN_PAD, tile, bid_s - 128, 128, tid); } \
    GSYNC(); CAT(12); \
    { const Params p = *kparams(); const int tid = opaque_tid(); conv_phase(p, e, tid); } \
    GSYNC(); CAT(13); \
    { const Params p = *kparams(); pg8::Gemm g{p.XCb, p.Wt_g + (size_t)e * 10 * 2 * 256 * 256, 10 * M_, 5120, 256}; DiagOrder S{NBLK, bid_s}; \
      EpiGates E{p.XCb, p.rg_b_a + e * DR, p.rg_b_i + e * DR, p.SP + e * DR, p.LA, p.UB}; \
      pg8::gemm_phase<EpiGates, DiagOrder, GEMM_ALIGN, SP2_GATES>((LAS unsigned char*)lds, g, S, E, wid_s); } \
    if (e == 0 && bid_s >= 128) { const Params p = *kparams(); const int tid = opaque_tid(); float* tile = (float*)lds;     \
      wt_convert256(p.even_w_out + (size_t)4096 * D_, p.Wt_eout + (size_t)D_ * 4096, 4096, D_, D_, tile, bid_s - 128, 128, tid); } \
    GSYNC(); CAT(14); \
    { const Params p = *kparams(); const int tid = opaque_tid(); scan1_phase(p, tid); } \
    GSYNC(); \
    { const Params p = *kparams(); const int tid = opaque_tid(); scan2_phase(p, tid); } \
    GSYNC(); CAT(15); \
    { const Params p = *kparams(); pg8::Gemm g{p.Ymix, p.Wt_oout + (size_t)e * D_ * DR, M_, D_, DR}; pg8::StaticOrder S; S.init(M_, D_, NBLK, bid_s); EpiAccumF32 E{p.X, D_, p.X}; \
      pg8::gemm_phase<EpiAccumF32, pg8::StaticOrder, GEMM_ALIGN, SP2_OUT>((LAS unsigned char*)lds, g, S, E, wid_s); } \
    GSYNC(); CAT(2); \
    { const Params p = *kparams(); const int tid = opaque_tid(); \
      if (e == 0) rmsnorm_phase<false, false>(p.X, nullptr, p.norm_w + 2 * D_, p.Hb, nullptr, tid, wid_s); \
      else rmsnorm_phase<true, false>(p.X, nullptr, p.final_norm_w, nullptr, p.out, tid, wid_s); } \
    if (e == 0) GSYNC(); \
  }
  LAYER_PAIR(0)
  LAYER_PAIR(1)
#undef LAYER_PAIR
#ifdef PROFILE_LEAK
  { __syncthreads();
    unsigned long long tsum_ = 0; for (int c_ = 0; c_ < 16; ++c_) if ((LEAK_DUR_MASK >> c_) & 1) tsum_ += prof[c_];
    const unsigned long long t_end = __builtin_amdgcn_s_memrealtime() + 2ull * tsum_;
    while (__builtin_amdgcn_s_memrealtime() < t_end) __builtin_amdgcn_s_sleep(8); }
#endif
#undef RUN
#undef GSYNC
}

static size_t carve(size_t& off, size_t bytes) { size_t o = off; off += (bytes + 255) & ~(size_t)255; return o; }

extern "C" void kernel_launch(void* const* d_in, const int* in_sizes, int n_in, void* d_out, int out_size, void* d_ws,
                              size_t ws_size, hipStream_t stream) {
  Params p{};
  {
    const float* ins[22];
    for (int i = 0; i < 22; ++i) ins[i] = (const float*)d_in[i];
    p.x = ins[0]; p.norm_w = ins[1]; p.final_norm_w = ins[2]; p.even_w_in = ins[3]; p.even_w_out = ins[4];
    p.hgrn_lb_logits = ins[5]; p.hgrn_norm_w = ins[6]; p.cmp_pe_k = ins[7]; p.cmp_w1_k = ins[8]; p.cmp_w2_k = ins[9];
    p.cmp_pe_v = ins[10]; p.cmp_w1_v = ins[11]; p.cmp_w2_v = ins[12]; p.odd_w_in = ins[13]; p.odd_w_out = ins[14];
    p.rg_conv_w = ins[15]; p.rg_conv_b = ins[16]; p.rg_w_a = ins[17]; p.rg_b_a = ins[18]; p.rg_w_i = ins[19];
    p.rg_b_i = ins[20]; p.rg_lambda = ins[21];
  }
  p.out = (float*)d_out;
  char* ws = (char*)d_ws;
  size_t off = 0;
  p.BAR = (unsigned*)(ws + carve(off, 2 * XCD_BAR_WORDS * 4));
  p.X = (float*)(ws + carve(off, (size_t)M_ * D_ * 4));
  p.Hb = (bf16_t*)(ws + carve(off, (size_t)M_ * D_ * 2));
  p.Wt_ein = (bf16_t*)(ws + carve(off, 2ull * EIN_PAD * D_ * 2));
  p.Wt_eout = (bf16_t*)(ws + carve(off, 2ull * D_ * 4096 * 2));
  p.Wt_oin = (bf16_t*)(ws + carve(off, 2ull * OIN * D_ * 2));
  p.Wt_oout = (bf16_t*)(ws + carve(off, 2ull * D_ * DR * 2));
  p.QS = (bf16_t*)(ws + carve(off, (size_t)M_ * 2048 * 2));
  p.XB = p.QS;
  p.GS = p.XB + (size_t)M_ * DR; p.LA = p.GS + (size_t)M_ * DR; p.UB = p.LA + (size_t)M_ * DR;
  p.LF = (float*)(ws + carve(off, (size_t)M_ * 2048 * 4));
  p.KK = (bf16_t*)(ws + carve(off, (size_t)M_ * 2048 * 2));
  p.AVT = (bf16_t*)(ws + carve(off, (size_t)M_ * 2048 * 2));
  p.LB = (float*)(ws + carve(off, 2 * 2048 * 4));
  p.KVC = (bf16_t*)(ws + carve(off, 2ull * NB * 4 * T_ * 128 * 2));
  p.W1T = (bf16_t*)(ws + carve(off, 2ull * 2 * 256 * 2048 * 2));
  p.ZC = (float*)(ws + carve(off, 2ull * NB * 4 * 128 * 256 * 4));
  p.C1 = (float*)(ws + carve(off, 2 * 2 * 128 * 4));
  p.KCb = (bf16_t*)(ws + carve(off, (size_t)NB * 4 * 128 * 128 * 2));
  p.VCT = (bf16_t*)(ws + carve(off, (size_t)NB * 4 * 128 * 128 * 2));
  p.Ymix = (bf16_t*)(ws + carve(off, (size_t)M_ * 4096 * 2));
  p.RS = (float*)(ws + carve(off, (size_t)M_ * 16 * 4));
  p.HID = (float*)(ws + carve(off, 2ull * NB * 4 * NCMP * 128 * 4));
  p.KC = (float*)(ws + carve(off, (size_t)NB * 4 * NCMP * 128 * 4));
  p.VC = (float*)(ws + carve(off, (size_t)NB * 4 * NCMP * 128 * 4));
  p.IMP = (float*)(ws + carve(off, (size_t)M_ * 4 * 32 * 4));
  p.SELM = (int*)(ws + carve(off, (size_t)M_ * 4 * 4));
  p.VT = (bf16_t*)(ws + carve(off, 2ull * NB * 4 * 128 * T_ * 2));
  p.Wt_g = (bf16_t*)(ws + carve(off, 2ull * 10 * 2 * 256 * 256 * 2));
  p.SP = (float*)(ws + carve(off, 2ull * DR * 4));
  size_t shared0 = off;
  p.PB = (bf16_t*)(ws + carve(off, (size_t)M_ * PB_W * 2));
  p.OA = (float*)(ws + carve(off, (size_t)M_ * 2048 * 4));
  p.PCMP = (float*)(ws + carve(off, (size_t)M_ * 16 * 128 * 4));
  p.YB = (float*)(ws + carve(off, (size_t)M_ * 2048 * 4));
  size_t end_even = off;
  off = shared0;
  p.XC = nullptr;
  p.XCb = (bf16_t*)(ws + carve(off, (size_t)M_ * DR * 2));
  p.SUMP = (float*)(ws + carve(off, (size_t)NB * 32 * DR * 4));
  p.SUMH = (float*)(ws + carve(off, (size_t)NB * 32 * DR * 4));
  if (off < end_even) off = end_even;
  if (off > ws_size) { fprintf(stderr, "workspace too small: need %zu have %zu\n", off, ws_size); return; }

  static int grid_blocks = 0;
  if (!grid_blocks) {
    int dev = 0, cus = 0, per_cu = 0;
    (void)hipGetDevice(&dev);
    (void)hipDeviceGetAttribute(&cus, hipDeviceAttributeMultiprocessorCount, dev);
    (void)hipFuncSetAttribute((const void*)mega, hipFuncAttributeMaxDynamicSharedMemorySize, LDS_BYTES);
    (void)hipOccupancyMaxActiveBlocksPerMultiprocessor(&per_cu, mega, NTHREADS, LDS_BYTES);
    if (per_cu < 1) fprintf(stderr, "occupancy query reports %d blocks/CU\n", per_cu);
    (void)hipGetLastError();
    if (cus < NBLK) fprintf(stderr, "device has %d CUs, kernel needs %d resident workgroups\n", cus, NBLK);
    grid_blocks = NBLK;
  }
  (void)hipMemsetAsync(p.BAR, 0, 2 * XCD_BAR_WORDS * 4, stream);
  hipLaunchKernelGGL(mega, dim3(grid_blocks), dim3(NTHREADS), LDS_BYTES, stream, p);
}
#endif
```
